# Optimizing an MI355X kernel written in HIP

```python
import functools
import jax, jax.numpy as jnp
from jax import lax
import numpy as np

D_MODEL = 1024
BATCH = 16
SEQ = 2048
DEPTH = 1
DEC_BATCH = 128
DEC_SEQ = 1
PAST_LEN = 16384
PAGE_SIZE = 128

N_HEADS = 16
N_KV_HEADS = 4
HEAD_DIM = 64
GROUP = N_HEADS // N_KV_HEADS
D_ATTN = N_HEADS * HEAD_DIM
D_KV = N_KV_HEADS * HEAD_DIM
WINDOW = 128
BLOCK = WINDOW
D_RNN = D_MODEL
N_RNN_BLOCKS = 16
RNN_BLOCK = D_RNN // N_RNN_BLOCKS
CONV_WIDTH = 4
LRU_C = 8.0
D_FF = 4 * D_MODEL
SPLITS = [D_ATTN, D_ATTN + D_KV, D_ATTN + 2 * D_KV, D_ATTN + 2 * D_KV + D_RNN,
          D_ATTN + 2 * D_KV + 2 * D_RNN, D_ATTN + 2 * D_KV + 2 * D_RNN + D_MODEL]
D_IN = D_ATTN + 2 * D_KV + 2 * D_RNN + 2 * D_MODEL
EPS = 1e-6

kernel_name = 'hybrid_swa_sink_rglru_decode_step'


def rmsnorm(x, g):
    xf = x.astype(jnp.float32)
    y = xf * lax.rsqrt(jnp.mean(xf * xf, axis=-1, keepdims=True) + EPS) * g.astype(jnp.float32)
    return y.astype(x.dtype)


def sink_softmax(s, mask, sink):
    s = jnp.where(mask, s, -jnp.inf)
    m = jnp.maximum(jnp.max(s, axis=-1, keepdims=True), sink)
    p = jnp.exp(s - m)
    return p / (jnp.sum(p, axis=-1, keepdims=True) + jnp.exp(sink - m))


def window_attention_prompt(q, k, v, sinks):
    B, T = q.shape[:2]
    nb = T // BLOCK
    qb = q.reshape(B, nb, BLOCK, N_KV_HEADS, GROUP, HEAD_DIM)
    kb = k.reshape(B, nb, BLOCK, N_KV_HEADS, HEAD_DIM)
    vb = v.reshape(B, nb, BLOCK, N_KV_HEADS, HEAD_DIM)
    pad = ((0, 0), (1, 0), (0, 0), (0, 0), (0, 0))
    kk = jnp.concatenate([jnp.pad(kb, pad)[:, :-1], kb], axis=2)
    vv = jnp.concatenate([jnp.pad(vb, pad)[:, :-1], vb], axis=2)
    s = jnp.einsum('bnqhgd,bnkhd->bnhgqk', qb, kk,
                   preferred_element_type=jnp.float32) * (HEAD_DIM ** -0.5)
    qi = jnp.arange(BLOCK)[:, None]
    kj = jnp.arange(2 * BLOCK)[None, :]
    diff = qi + BLOCK - kj
    band = (diff >= 0) & (diff <= WINDOW)
    has_prev = (jnp.arange(nb)[:, None] > 0) | (kj >= BLOCK)
    mask = (band[None] & has_prev[:, None, :])[None, :, None, None]
    sink = sinks.astype(jnp.float32).reshape(N_KV_HEADS, GROUP)[None, None, :, :, None, None]
    p = sink_softmax(s, mask, sink)
    o = jnp.einsum('bnhgqk,bnkhd->bnqhgd', p.astype(v.dtype), vv)
    return o.reshape(B, T, D_ATTN), k[:, -WINDOW:], v[:, -WINDOW:]


def window_attention_sample(k_buf, v_buf, q, k, v, sinks):
    B, T = q.shape[:2]
    qh = q.reshape(B, T, N_KV_HEADS, GROUP, HEAD_DIM)
    kk = jnp.concatenate([k_buf.astype(k.dtype), k], axis=1)
    vv = jnp.concatenate([v_buf.astype(v.dtype), v], axis=1)
    s = jnp.einsum('bqhgd,bkhd->bhgqk', qh, kk,
                   preferred_element_type=jnp.float32) * (HEAD_DIM ** -0.5)
    diff = jnp.arange(T)[:, None] + WINDOW - jnp.arange(WINDOW + T)[None, :]
    mask = ((diff >= 0) & (diff <= WINDOW))[None, None, None]
    sink = sinks.astype(jnp.float32).reshape(N_KV_HEADS, GROUP)[None, :, :, None, None]
    p = sink_softmax(s, mask, sink)
    o = jnp.einsum('bhgqk,bkhd->bqhgd', p.astype(v.dtype), vv)
    return o.reshape(B, T, D_ATTN), kk[:, -WINDOW:], vv[:, -WINDOW:]


def causal_conv(u, prev, conv_w, conv_b):
    T = u.shape[1]
    up = jnp.concatenate([prev.astype(u.dtype), u], axis=1)
    out = conv_b + sum(up[:, i:i + T] * conv_w[i] for i in range(CONV_WIDTH))
    return out, up[:, -(CONV_WIDTH - 1):]


def rg_lru(x, h0, positions, w_a, b_a, w_x, b_x, lam):
    B, T, _ = x.shape
    xf = x.astype(jnp.float32)
    xb = xf.reshape(B, T, N_RNN_BLOCKS, RNN_BLOCK)
    r = jax.nn.sigmoid(jnp.einsum('btnc,ncd->btnd', xb, w_a.astype(jnp.float32)).reshape(B, T, D_RNN)
                       + b_a.astype(jnp.float32))
    i = jax.nn.sigmoid(jnp.einsum('btnc,ncd->btnd', xb, w_x.astype(jnp.float32)).reshape(B, T, D_RNN)
                       + b_x.astype(jnp.float32))
    log_a = -LRU_C * r * jax.nn.softplus(-lam.astype(jnp.float32))
    a = jnp.exp(log_a)
    mult = jnp.where((positions == 0)[None, :, None], 1.0, jnp.sqrt(-jnp.expm1(2.0 * log_a)))
    b = mult * i * xf
    b = b.at[:, 0].add(a[:, 0] * h0.astype(jnp.float32))

    def combine(left, right):
        a1, b1 = left
        a2, b2 = right
        return a1 * a2, a2 * b1 + b2

    _, h = lax.associative_scan(combine, (a, b), axis=1)
    return h, h[:, -1]


def hybrid_layer(x, positions, attn_fn, conv_prev, h0, w_in, w_out, sinks, conv_w, conv_b,
                 lru_w_a, lru_b_a, lru_w_x, lru_b_x, lru_lambda, w_up, w_down,
                 g_pre_mix, g_post_mix, g_pre_ffn, g_post_ffn):
    B, T = x.shape[:2]
    xn = rmsnorm(x, g_pre_mix)
    z = jnp.einsum('btd,de->bte', xn, w_in)
    q, k, v, u, g_branch, gate_a, gate_r = jnp.split(z, SPLITS, axis=-1)
    attn_out, k_state, v_state = attn_fn(q.reshape(B, T, N_HEADS, HEAD_DIM),
                                         k.reshape(B, T, N_KV_HEADS, HEAD_DIM),
                                         v.reshape(B, T, N_KV_HEADS, HEAD_DIM), sinks)
    uc, conv_state = causal_conv(u, conv_prev, conv_w, conv_b)
    h, h_last = rg_lru(uc, h0, positions, lru_w_a, lru_b_a, lru_w_x, lru_b_x, lru_lambda)
    rnn_out = jax.nn.gelu(g_branch.astype(jnp.float32)) * h
    merged = (jax.nn.sigmoid(gate_a.astype(jnp.float32)) * attn_out.astype(jnp.float32)
              + jax.nn.sigmoid(gate_r.astype(jnp.float32)) * rnn_out).astype(x.dtype)
    mix = jnp.einsum('btd,de->bte', merged, w_out)
    x = x + rmsnorm(mix, g_post_mix)
    hn = rmsnorm(x, g_pre_ffn)
    f = jnp.einsum('btf,fd->btd', jnp.square(jax.nn.relu(jnp.einsum('btd,df->btf', hn, w_up))), w_down)
    x = x + rmsnorm(f, g_post_ffn)
    return x, k_state, v_state, conv_state, h_last


def setup_inputs(seed: int = 0) -> dict:
    key = jax.random.key(seed)
    ks = jax.random.split(key, 24)
    f32 = jnp.float32
    nrm = lambda k, shape, scale: jax.random.normal(k, shape, f32) * scale
    a0 = jax.random.uniform(ks[14], (DEPTH, D_RNN), f32, 0.9, 0.999)
    return {
        'x_prompt': nrm(ks[0], (BATCH, SEQ, D_MODEL), 1.0),
        'x_sample': nrm(ks[1], (DEC_BATCH, DEC_SEQ, D_MODEL), 1.0),
        'cache_k_win': nrm(ks[2], (DEPTH, DEC_BATCH, WINDOW, N_KV_HEADS, HEAD_DIM), 1.0),
        'cache_v_win': nrm(ks[3], (DEPTH, DEC_BATCH, WINDOW, N_KV_HEADS, HEAD_DIM), 1.0),
        'state_conv': nrm(ks[4], (DEPTH, DEC_BATCH, CONV_WIDTH - 1, D_RNN), 1.0),
        'state_lru': nrm(ks[5], (DEPTH, DEC_BATCH, D_RNN), 0.5),
        'w_in': nrm(ks[6], (DEPTH, D_MODEL, D_IN), D_MODEL ** -0.5),
        'w_out': nrm(ks[7], (DEPTH, D_MODEL, D_MODEL), D_MODEL ** -0.5),
        'sinks': nrm(ks[8], (DEPTH, N_HEADS), 0.5),
        'conv_w': nrm(ks[9], (DEPTH, CONV_WIDTH, D_RNN), CONV_WIDTH ** -0.5),
        'conv_b': nrm(ks[10], (DEPTH, D_RNN), 0.02),
        'lru_w_a': nrm(ks[11], (DEPTH, N_RNN_BLOCKS, RNN_BLOCK, RNN_BLOCK), RNN_BLOCK ** -0.5),
        'lru_b_a': nrm(ks[12], (DEPTH, D_RNN), 0.02),
        'lru_w_x': nrm(ks[13], (DEPTH, N_RNN_BLOCKS, RNN_BLOCK, RNN_BLOCK), RNN_BLOCK ** -0.5),
        'lru_b_x': nrm(ks[15], (DEPTH, D_RNN), 0.02),
        'lru_lambda': jnp.log(a0) - jnp.log1p(-a0),
        'w_up': nrm(ks[16], (DEPTH, D_MODEL, D_FF), D_MODEL ** -0.5),
        'w_down': nrm(ks[17], (DEPTH, D_FF, D_MODEL), D_FF ** -0.5),
        'g_pre_mix': 1.0 + nrm(ks[18], (DEPTH, D_MODEL), 0.02),
        'g_post_mix': 1.0 + nrm(ks[19], (DEPTH, D_MODEL), 0.02),
        'g_pre_ffn': 1.0 + nrm(ks[20], (DEPTH, D_MODEL), 0.02),
        'g_post_ffn': 1.0 + nrm(ks[21], (DEPTH, D_MODEL), 0.02),
    }


def reference(x_prompt, x_sample, cache_k_win, cache_v_win, state_conv, state_lru,
              w_in, w_out, sinks, conv_w, conv_b, lru_w_a, lru_b_a, lru_w_x, lru_b_x, lru_lambda,
              w_up, w_down, g_pre_mix, g_post_mix, g_pre_ffn, g_post_ffn):
    B, T = x_prompt.shape[:2]
    DB, DT = x_sample.shape[:2]
    pos_prompt = jnp.arange(T)
    pos_sample = PAST_LEN + jnp.arange(DT)
    yp, ys = x_prompt, x_sample
    kp, vp, cp, hp, kq, vq, cq, hq = [], [], [], [], [], [], [], []
    for l in range(DEPTH):
        lp = (w_in[l], w_out[l], sinks[l], conv_w[l], conv_b[l], lru_w_a[l], lru_b_a[l],
              lru_w_x[l], lru_b_x[l], lru_lambda[l], w_up[l], w_down[l],
              g_pre_mix[l], g_post_mix[l], g_pre_ffn[l], g_post_ffn[l])
        yp, k_s, v_s, c_s, h_s = hybrid_layer(
            yp, pos_prompt, window_attention_prompt,
            jnp.zeros((B, CONV_WIDTH - 1, D_RNN), yp.dtype), jnp.zeros((B, D_RNN), jnp.float32), *lp)
        kp.append(k_s); vp.append(v_s); cp.append(c_s); hp.append(h_s)
        ys, k_s, v_s, c_s, h_s = hybrid_layer(
            ys, pos_sample, functools.partial(window_attention_sample, cache_k_win[l], cache_v_win[l]),
            state_conv[l], state_lru[l], *lp)
        kq.append(k_s); vq.append(v_s); cq.append(c_s); hq.append(h_s)
    k_win_prompt = jnp.stack(kp)
    v_win_prompt = jnp.stack(vp)
    conv_prompt = jnp.stack(cp)
    lru_prompt = jnp.stack(hp)
    k_win_sample = jnp.stack(kq)
    v_win_sample = jnp.stack(vq)
    conv_sample = jnp.stack(cq)
    lru_sample = jnp.stack(hq)
    return (yp, ys, k_win_prompt, v_win_prompt, conv_prompt, lru_prompt,
            k_win_sample, v_win_sample, conv_sample, lru_sample)
```

```cpp
#include <hip/hip_runtime.h>
#include <hip/hip_cooperative_groups.h>
#include <cstdio>
#include <cstdint>
namespace cg = cooperative_groups;

#define LAS __attribute__((address_space(3)))
typedef unsigned short bf16;
typedef unsigned v4u __attribute__((ext_vector_type(4)));
typedef unsigned v2u __attribute__((ext_vector_type(2)));
typedef float f32x4 __attribute__((ext_vector_type(4)));
typedef float f32x2 __attribute__((ext_vector_type(2)));
typedef short bf16x8 __attribute__((ext_vector_type(8)));
typedef short s16x4 __attribute__((ext_vector_type(4)));
typedef __bf16 b16x2 __attribute__((ext_vector_type(2)));

__device__ __forceinline__ unsigned pk2(float lo, float hi) { f32x2 v = {lo, hi}; b16x2 r = __builtin_convertvector(v, b16x2); return __builtin_bit_cast(unsigned, r); }
__device__ __forceinline__ bf16 f2bf(float f) { return (bf16)(pk2(f, 0.f) & 0xffffu); }
__device__ __forceinline__ float bf2f(bf16 h) { return __uint_as_float((unsigned)h << 16); }
__device__ __forceinline__ float bflo(unsigned w) { return __uint_as_float(w << 16); }
__device__ __forceinline__ float bfhi(unsigned w) { return __uint_as_float(w & 0xffff0000u); }
__device__ __forceinline__ float sigmoidf_(float x) { return __builtin_amdgcn_rcpf(1.0f + __expf(-x)); }
__device__ __forceinline__ float gelu_tanh(float x) { const float y = 0.7978845608028654f * (x + 0.044715f * x * x * x); return x * sigmoidf_(2.0f * y); }
__device__ __forceinline__ int opaque_tid() { int t = threadIdx.x; asm volatile("" : "+v"(t)); return t; }
__device__ __forceinline__ float wave_sum(float v) {
#pragma unroll
    for (int o = 1; o < 64; o <<= 1) v += __shfl_xor(v, o);
    return v;
}
__device__ __forceinline__ float wave_max(float v) {
#pragma unroll
    for (int o = 1; o < 64; o <<= 1) v = fmaxf(v, __shfl_xor(v, o));
    return v;
}

namespace pg8 {
#define PG8_LAS __attribute__((address_space(3)))
typedef unsigned short bf16_t;
typedef short bf16x8 __attribute__((ext_vector_type(8)));
typedef float f32x4 __attribute__((ext_vector_type(4)));
typedef unsigned u32x4 __attribute__((ext_vector_type(4)));
constexpr int BM = 256, BK = 64, HALF = 128, HTB = HALF * BK * 2, STAGE_BYTES = 8 * HTB, NXCD = 8, WGM = 8;

__host__ __device__ __forceinline__ int lds_byte(int r, int c) { const int st = (r >> 4) * 2 + (c >> 5), rr = r & 15, cc = c & 31, ob = rr * 64 + cc * 2; return st * 1024 + (ob ^ (((ob >> 9) & 1) << 5)); }
__host__ __device__ __forceinline__ void stage_rc(int b, int& R, int& C) { const int st = b / 1024, sb = b % 1024, swz = sb ^ (((sb >> 9) & 1) << 5); R = (st >> 1) * 16 + swz / 64; C = (st & 1) * 32 + (swz % 64) / 2; }
__host__ __device__ __forceinline__ int perm32(int rho) { const int n = rho >> 4, i = rho & 15; return 8 * (i >> 2) + 4 * n + (i & 3); }

struct Unit { int pm, pn; };
struct Gemm { const bf16_t* A; const bf16_t* Bt; int M, N, K; };

struct StaticOrder {
    int nM, nN, nwg, G, c;
    __host__ __device__ void init(int M, int N, int G_, int c_) { nM = M / BM; nN = N / BM; nwg = nM * nN; G = G_; c = c_; }
    __host__ __device__ bool next(int i, Unit& u) const {
        const long L = (long)i * G + c; if (L >= nwg) return false;
        int wgid = (int)L; { const int q = nwg / NXCD, r = nwg % NXCD, xcd = wgid % NXCD, off = wgid / NXCD; wgid = (xcd < r ? xcd * (q + 1) : r * (q + 1) + (xcd - r) * q) + off; }
        const int nig = WGM * nN, gid = wgid / nig, fm = gid * WGM, gsz = (nM - fm) < WGM ? (nM - fm) : WGM;
        u.pm = fm + ((wgid % nig) % gsz); u.pn = (wgid % nig) / gsz; return true;
    }
    __device__ __forceinline__ void a_ready(const Unit&) const {}
    __device__ __forceinline__ void done(const Unit&) const {}
};

template <int ACT  > struct EpiBf16 {
    static constexpr bool PERM = true, AFTER_DRAIN = false, ROWSCALE = (ACT == 3);
    bf16_t* O; int ldc; const float* rowscale;
    __device__ __forceinline__ void operator()(const f32x4 (&acc)[2][2][4][2], const Unit& u, int wr, int wc, int fr, int fq, const float (&rsc)[2][4]) const {
        const int row0 = u.pm * BM + wr * 64 + fr; const int col0 = u.pn * BM + wc * 32 + 8 * fq;
#pragma unroll
        for (int ai = 0; ai < 2; ++ai)
#pragma unroll
            for (int m = 0; m < 4; ++m) { bf16_t* rowp = O + (size_t)(row0 + ai * HALF + m * 16) * ldc + col0;
                const float q2 = (ACT == 3) ? rsc[ai][m] * rsc[ai][m] : 1.0f;
#pragma unroll
                for (int bj = 0; bj < 2; ++bj) { f32x4 v0 = acc[ai][bj][m][0], v1 = acc[ai][bj][m][1];
                    if (ACT >= 2) {
#pragma unroll
                        for (int e = 0; e < 4; ++e) { const float a = fmaxf(v0[e], 0.f), b = fmaxf(v1[e], 0.f); v0[e] = a * a * q2; v1[e] = b * b * q2; } }
                    u32x4 w; w.x = pk2(v0[0], v0[1]); w.y = pk2(v0[2], v0[3]); w.z = pk2(v1[0], v1[1]); w.w = pk2(v1[2], v1[3]);
                    *(u32x4*)(rowp + bj * HALF) = w; } }
    }
};
struct EpiF32 {
    static constexpr bool PERM = false, AFTER_DRAIN = false, ROWSCALE = false;
    float* O; int ldc;
    __device__ __forceinline__ void operator()(const f32x4 (&acc)[2][2][4][2], const Unit& u, int wr, int wc, int fr, int fq, const float (&rsc)[2][4]) const {
        const int row0 = u.pm * BM + wr * 64 + fr; const int col0 = u.pn * BM + wc * 32 + 4 * fq;
#pragma unroll
        for (int ai = 0; ai < 2; ++ai)
#pragma unroll
            for (int m = 0; m < 4; ++m) { float* rowp = O + (size_t)(row0 + ai * HALF + m * 16) * ldc + col0;
#pragma unroll
                for (int bj = 0; bj < 2; ++bj)
#pragma unroll
                    for (int n = 0; n < 2; ++n) *(f32x4*)(rowp + bj * HALF + n * 16) = acc[ai][bj][m][n]; }
    }
};


struct OneUnit { Unit u; bool valid;
    __device__ __forceinline__ bool next(int i, Unit& o) const { if (i == 0 && valid) { o = u; return true; } return false; }
    __device__ __forceinline__ void a_ready(const Unit&) const {}
    __device__ __forceinline__ void done(const Unit&) const {} };
struct PanelRms {
    float* xbuf;
    unsigned* cnt;
    __device__ __forceinline__ void run(const f32x4 (&v)[2][2][4][2], const Unit& u, int wr, int wc, int fr, int fq, PG8_LAS unsigned char* lds, int wid, int lane) const {
        PG8_LAS float* P = (PG8_LAS float*)lds;
        PG8_LAS float* S = (PG8_LAS float*)(lds + 4096);
#pragma unroll
        for (int ai = 0; ai < 2; ++ai)
#pragma unroll
            for (int m = 0; m < 4; ++m) { float s = 0.f;
#pragma unroll
                for (int bj = 0; bj < 2; ++bj)
#pragma unroll
                    for (int n = 0; n < 2; ++n) { const f32x4 x = v[ai][bj][m][n]; s += (x[0] * x[0] + x[1] * x[1]) + (x[2] * x[2] + x[3] * x[3]); }
                s += __shfl_xor(s, 16); s += __shfl_xor(s, 32);
                if (fq == 0) P[(ai * HALF + wr * 64 + m * 16 + fr) * 4 + wc] = s; }
        asm volatile("s_waitcnt lgkmcnt(0)" ::: "memory"); __builtin_amdgcn_s_barrier(); asm volatile("" ::: "memory");
        const int row = wid * 32 + (lane & 31);
        if (lane < 32) { const f32x4 p = *(const PG8_LAS f32x4*)(P + row * 4);
            __hip_atomic_store(xbuf + ((size_t)(u.pm * BM + row) * 4 + u.pn), (p[0] + p[1]) + (p[2] + p[3]), __ATOMIC_RELAXED, __HIP_MEMORY_SCOPE_AGENT); }
        asm volatile("s_waitcnt vmcnt(0)" ::: "memory");
        if (lane == 0) __hip_atomic_fetch_add(cnt + 64 * u.pm, 1u, __ATOMIC_RELAXED, __HIP_MEMORY_SCOPE_AGENT);
        if (wid == 0) { unsigned sp = 0;
            while ((unsigned)__builtin_amdgcn_readfirstlane(__hip_atomic_load(cnt + 64 * u.pm, __ATOMIC_RELAXED, __HIP_MEMORY_SCOPE_AGENT)) < 32u) { __builtin_amdgcn_s_sleep(2); if (++sp > (1u << 22)) break; }
            __builtin_amdgcn_fence(__ATOMIC_ACQUIRE, "agent"); }
        asm volatile("s_waitcnt vmcnt(0) lgkmcnt(0)" ::: "memory"); __builtin_amdgcn_s_barrier(); asm volatile("" ::: "memory");
        if (lane < 32) { const float* slot = xbuf + (size_t)(u.pm * BM + row) * 4; float t = 0.f;
#pragma unroll
            for (int k = 0; k < 4; ++k) t += __hip_atomic_load(slot + k, __ATOMIC_RELAXED, __HIP_MEMORY_SCOPE_AGENT);
            S[row] = 1.0f / sqrtf(t * (1.0f / 1024.0f) + 1e-6f); }
        asm volatile("s_waitcnt lgkmcnt(0)" ::: "memory"); __builtin_amdgcn_s_barrier(); asm volatile("" ::: "memory");
    }
};
struct PanelPublish {
    float* xbuf; unsigned* cnt; float* rs2;
    __device__ __forceinline__ void run(const f32x4 (&v)[2][2][4][2], const Unit& u, int wr, int wc, int fr, int fq, PG8_LAS unsigned char* lds, int wid, int lane) const {
        PG8_LAS float* P = (PG8_LAS float*)(lds + 8192);
#pragma unroll
        for (int ai = 0; ai < 2; ++ai)
#pragma unroll
            for (int m = 0; m < 4; ++m) { float s = 0.f;
#pragma unroll
                for (int bj = 0; bj < 2; ++bj)
#pragma unroll
                    for (int n = 0; n < 2; ++n) { const f32x4 x = v[ai][bj][m][n]; s += (x[0] * x[0] + x[1] * x[1]) + (x[2] * x[2] + x[3] * x[3]); }
                s += __shfl_xor(s, 16); s += __shfl_xor(s, 32);
                if (fq == 0) P[(ai * HALF + wr * 64 + m * 16 + fr) * 4 + wc] = s; }
        asm volatile("s_waitcnt lgkmcnt(0)" ::: "memory"); __builtin_amdgcn_s_barrier(); asm volatile("" ::: "memory");
        const int row = wid * 32 + (lane & 31);
        if (lane < 32) { const f32x4 p = *(const PG8_LAS f32x4*)(P + row * 4);
            __hip_atomic_store(xbuf + ((size_t)(u.pm * BM + row) * 4 + u.pn), (p[0] + p[1]) + (p[2] + p[3]), __ATOMIC_RELAXED, __HIP_MEMORY_SCOPE_AGENT); }
        asm volatile("s_waitcnt vmcnt(0)" ::: "memory");
        unsigned old = 0u; if (lane == 0) old = __hip_atomic_fetch_add(cnt + 64 * u.pm, 1u, __ATOMIC_RELAXED, __HIP_MEMORY_SCOPE_AGENT);
        old = (unsigned)__builtin_amdgcn_readfirstlane(old);
        if (old == 31u) {
            __builtin_amdgcn_fence(__ATOMIC_ACQUIRE, "agent");
#pragma unroll
            for (int rr = 0; rr < 4; ++rr) { const int r = lane + 64 * rr; const float* slot = xbuf + (size_t)(u.pm * BM + r) * 4; float t = 0.f;
#pragma unroll
                for (int k = 0; k < 4; ++k) t += __hip_atomic_load(slot + k, __ATOMIC_RELAXED, __HIP_MEMORY_SCOPE_AGENT);
                rs2[u.pm * BM + r] = 1.0f / sqrtf(t * (1.0f / 1024.0f) + 1e-6f); } }
    }
};
struct EpiRmsResRms {
    static constexpr bool PERM = true, AFTER_DRAIN = true, ROWSCALE = false;
    const bf16_t* xs; const float* rsx; bf16_t* x1b; const float* g1; PanelRms st1; PanelPublish st2;
    __device__ __forceinline__ void fused(f32x4 (&acc)[2][2][4][2], const Unit& u, int wr, int wc, int fr, int fq, PG8_LAS unsigned char* lds, int wid, int lane) const {
        const PG8_LAS float* S = (const PG8_LAS float*)(lds + 4096);
        const int col0 = u.pn * BM + wc * 32 + 8 * fq;
        u32x4 pre[2][4][2]; float irs[2][4];
#pragma unroll
        for (int ai = 0; ai < 2; ++ai)
#pragma unroll
            for (int m = 0; m < 4; ++m) { const int grow = u.pm * BM + ai * HALF + wr * 64 + m * 16 + fr; const size_t off = (size_t)grow * 1024 + col0;
                irs[ai][m] = rsx[grow];
#pragma unroll
                for (int bj = 0; bj < 2; ++bj) pre[ai][m][bj] = *(const u32x4*)(xs + off + bj * HALF); }
        st1.run(acc, u, wr, wc, fr, fq, lds, wid, lane);
        f32x4 gv[2][2];
#pragma unroll
        for (int bj = 0; bj < 2; ++bj)
#pragma unroll
            for (int n = 0; n < 2; ++n) gv[bj][n] = *(const f32x4*)(g1 + col0 + bj * HALF + n * 4);
#pragma unroll
        for (int ai = 0; ai < 2; ++ai)
#pragma unroll
            for (int m = 0; m < 4; ++m) { const int r = ai * HALF + wr * 64 + m * 16 + fr; const float rs = S[r]; const float ix = 1.0f / irs[ai][m];
#pragma unroll
                for (int bj = 0; bj < 2; ++bj) { const u32x4 p = pre[ai][m][bj];
                    const f32x4 b0 = (f32x4){__uint_as_float(p.x << 16), __uint_as_float(p.x & 0xffff0000u), __uint_as_float(p.y << 16), __uint_as_float(p.y & 0xffff0000u)};
                    const f32x4 b1 = (f32x4){__uint_as_float(p.z << 16), __uint_as_float(p.z & 0xffff0000u), __uint_as_float(p.w << 16), __uint_as_float(p.w & 0xffff0000u)};
                    const f32x4 a0 = b0 * ix + acc[ai][bj][m][0] * rs * gv[bj][0], a1 = b1 * ix + acc[ai][bj][m][1] * rs * gv[bj][1];
                    acc[ai][bj][m][0] = a0; acc[ai][bj][m][1] = a1;
                    u32x4 w; w.x = pk2(a0[0], a0[1]); w.y = pk2(a0[2], a0[3]); w.z = pk2(a1[0], a1[1]); w.w = pk2(a1[2], a1[3]);
                    *(u32x4*)(x1b + (size_t)(u.pm * BM + r) * 1024 + col0 + bj * HALF) = w; }
                asm volatile("" : "+v"(acc[ai][0][m][0]), "+v"(acc[ai][0][m][1]), "+v"(acc[ai][1][m][0]), "+v"(acc[ai][1][m][1])); }
        asm volatile("" ::: "memory");
        st2.run(acc, u, wr, wc, fr, fq, lds, wid, lane);
    }
};
struct EpiRmsRes {
    static constexpr bool PERM = true, AFTER_DRAIN = true, ROWSCALE = false;
    const bf16_t* x1b; float* out; const float* g1; PanelRms st;
    __device__ __forceinline__ void fused(f32x4 (&acc)[2][2][4][2], const Unit& u, int wr, int wc, int fr, int fq, PG8_LAS unsigned char* lds, int wid, int lane) const {
        const PG8_LAS float* S = (const PG8_LAS float*)(lds + 4096);
        const int col0 = u.pn * BM + wc * 32 + 8 * fq;
        u32x4 pre[2][4][2];
#pragma unroll
        for (int ai = 0; ai < 2; ++ai)
#pragma unroll
            for (int m = 0; m < 4; ++m) { const size_t off = (size_t)(u.pm * BM + ai * HALF + wr * 64 + m * 16 + fr) * 1024 + col0;
#pragma unroll
                for (int bj = 0; bj < 2; ++bj) pre[ai][m][bj] = *(const u32x4*)(x1b + off + bj * HALF); }
        st.run(acc, u, wr, wc, fr, fq, lds, wid, lane);
        f32x4 gv[2][2];
#pragma unroll
        for (int bj = 0; bj < 2; ++bj)
#pragma unroll
            for (int n = 0; n < 2; ++n) gv[bj][n] = *(const f32x4*)(g1 + col0 + bj * HALF + n * 4);
#pragma unroll
        for (int ai = 0; ai < 2; ++ai)
#pragma unroll
            for (int m = 0; m < 4; ++m) { const int r = ai * HALF + wr * 64 + m * 16 + fr; const float rs = S[r]; const size_t off = (size_t)(u.pm * BM + r) * 1024 + col0;
#pragma unroll
                for (int bj = 0; bj < 2; ++bj) { const u32x4 p = pre[ai][m][bj];
                    const f32x4 b0 = (f32x4){__uint_as_float(p.x << 16), __uint_as_float(p.x & 0xffff0000u), __uint_as_float(p.y << 16), __uint_as_float(p.y & 0xffff0000u)};
                    const f32x4 b1 = (f32x4){__uint_as_float(p.z << 16), __uint_as_float(p.z & 0xffff0000u), __uint_as_float(p.w << 16), __uint_as_float(p.w & 0xffff0000u)};
                    *(f32x4*)(out + off + bj * HALF) = b0 + acc[ai][bj][m][0] * rs * gv[bj][0];
                    *(f32x4*)(out + off + bj * HALF + 4) = b1 + acc[ai][bj][m][1] * rs * gv[bj][1]; } }
    }
};

template <class Epi, class Sched, bool ALIGN_EPI = false, bool SP2 = false>
__device__ __forceinline__ void gemm_phase(PG8_LAS unsigned char* lds, const Gemm g, const Sched& S, const Epi& E) {
    const int tid = opaque_tid(), wid = __builtin_amdgcn_readfirstlane(tid >> 6), lane = tid & 63, wr = wid >> 2, wc = wid & 3, fr = lane & 15, fq = lane >> 4;
    const int K = g.K, nt = K / BK;
    unsigned voffA[2], voffB[2];
#pragma unroll
    for (int i = 0; i < 2; ++i) { int R, C; stage_rc(tid * 16 + i * 8192, R, C); const int Rb = Epi::PERM ? ((R & ~31) + perm32(R & 31)) : R;
        voffA[i] = (unsigned)(R * K + C) * 2u; voffB[i] = (unsigned)(Rb * K + C) * 2u; }
    const size_t kstep = (size_t)(BK * 2);
    const size_t hstep = (size_t)HALF * K * 2;
    const size_t tstep = 2 * hstep;
    const unsigned ldsw = (unsigned)wid * 1024u;
    const int aoff = lds_byte(wr * 64 + fr, fq * 8), boff = lds_byte(wc * 32 + fr, fq * 8);
#define PG8_SA(b, h) (((b) * 2 + (h)) * HTB)
#define PG8_SB(b, h) ((4 + (b) * 2 + (h)) * HTB)
#define PG8_STAGE(bufoff, gbase, voff) do { _Pragma("unroll") for (int _i = 0; _i < 2; ++_i) \
        __builtin_amdgcn_global_load_lds((const unsigned*)((const char*)(gbase) + (voff)[_i]), (PG8_LAS unsigned*)(lds + (bufoff) + ldsw + _i * 8192), 16, 0, 0); } while (0)
#define PG8_LDA(dst, b, h) do { _Pragma("unroll") for (int m = 0; m < 4; ++m) _Pragma("unroll") for (int k = 0; k < 2; ++k) dst[m][k] = *(const PG8_LAS bf16x8*)(lds + PG8_SA(b, h) + aoff + m * 2048 + k * 1024); } while (0)
#define PG8_LDB(dst, b, h) do { _Pragma("unroll") for (int n = 0; n < 2; ++n) _Pragma("unroll") for (int k = 0; k < 2; ++k) dst[n][k] = *(const PG8_LAS bf16x8*)(lds + PG8_SB(b, h) + boff + n * 2048 + k * 1024); } while (0)
#define PG8_MMA(ai, bj, At, Bt) do { __builtin_amdgcn_s_setprio(1); _Pragma("unroll") for (int m = 0; m < 4; ++m) _Pragma("unroll") for (int n = 0; n < 2; ++n) _Pragma("unroll") for (int k = 0; k < 2; ++k) \
        acc[ai][bj][m][n] = __builtin_amdgcn_mfma_f32_16x16x32_bf16(Bt[n][k], At[m][k], acc[ai][bj][m][n], 0, 0, 0); __builtin_amdgcn_s_setprio(0); } while (0)
#define PG8_WAIT_V(n) asm volatile("s_waitcnt vmcnt(" #n ")" ::: "memory")
#define PG8_WAIT_L(n) asm volatile("s_waitcnt lgkmcnt(" #n ")" ::: "memory")
#define PG8_BAR __builtin_amdgcn_s_barrier()
#define PG8_SCHED __builtin_amdgcn_sched_barrier(0)
    Unit cur, nxt; int ui = 0;
    if (!S.next(0, cur)) return;
    f32x4 acc[2][2][4][2];
#pragma unroll
    for (int a = 0; a < 2; ++a)
#pragma unroll
        for (int b = 0; b < 2; ++b)
#pragma unroll
            for (int m = 0; m < 4; ++m)
#pragma unroll
                for (int n = 0; n < 2; ++n) acc[a][b][m][n] = (f32x4){0.f, 0.f, 0.f, 0.f};
    bf16x8 At[4][2], B0[2][2], B1[2][2];
    float rsc[2][4] = {{1.f, 1.f, 1.f, 1.f}, {1.f, 1.f, 1.f, 1.f}};
    const char* cA = (const char*)g.A + (size_t)cur.pm * tstep; const char* cB = (const char*)g.Bt + (size_t)cur.pn * tstep;
    S.a_ready(cur);
    if constexpr (SP2) {
        PG8_STAGE(PG8_SB(0, 0), cB, voffB); PG8_STAGE(PG8_SB(0, 1), cB + hstep, voffB); PG8_STAGE(PG8_SA(0, 0), cA, voffA); PG8_STAGE(PG8_SA(0, 1), cA + hstep, voffA);
        if (wr == 1) PG8_BAR;
        PG8_WAIT_V(2); PG8_BAR;
        PG8_STAGE(PG8_SB(1, 0), cB + kstep, voffB); PG8_STAGE(PG8_SA(1, 0), cA + kstep, voffA); PG8_STAGE(PG8_SB(1, 1), cB + hstep + kstep, voffB);
        PG8_WAIT_V(6); PG8_BAR;
    } else {
        PG8_STAGE(PG8_SB(0, 0), cB, voffB); PG8_STAGE(PG8_SA(0, 0), cA, voffA); PG8_STAGE(PG8_SB(0, 1), cB + hstep, voffB); PG8_STAGE(PG8_SA(0, 1), cA + hstep, voffA);
        if (wr == 1) PG8_BAR;
        PG8_WAIT_V(4); PG8_BAR;
        PG8_STAGE(PG8_SB(1, 0), cB + kstep, voffB); PG8_STAGE(PG8_SA(1, 0), cA + kstep, voffA); PG8_STAGE(PG8_SB(1, 1), cB + hstep + kstep, voffB);
        PG8_WAIT_V(6); PG8_BAR;
    }
    for (;;) {
        const bool has_next = S.next(ui + 1, nxt);
        const char* nA = has_next ? (const char*)g.A + (size_t)nxt.pm * tstep : cA; const char* nB = has_next ? (const char*)g.Bt + (size_t)nxt.pn * tstep : cB;
        for (int t = 0; t < nt; t += 2) {
            const bool last = (t == nt - 2);
            const char* a1 = cA + (size_t)(t + 1) * kstep;
            const char* a2 = last ? nA : cA + (size_t)(t + 2) * kstep; const char* b2 = last ? nB : cB + (size_t)(t + 2) * kstep;
            const char* a3 = a2 + kstep; const char* b3 = b2 + kstep;
            if (last && has_next) S.a_ready(nxt);
            if constexpr (!Epi::AFTER_DRAIN) { if constexpr (Epi::ROWSCALE) { if (last) {
#pragma unroll
                for (int ai = 0; ai < 2; ++ai)
#pragma unroll
                    for (int m = 0; m < 4; ++m) rsc[ai][m] = E.rowscale[cur.pm * BM + ai * HALF + wr * 64 + m * 16 + fr]; } } }
            if constexpr (SP2) {
            PG8_LDB(B0, 0, 0); PG8_LDB(B1, 0, 1); PG8_SCHED; PG8_LDA(At, 0, 0); PG8_STAGE(PG8_SA(1, 1), a1 + hstep, voffA);
            PG8_WAIT_V(8); PG8_WAIT_L(0); PG8_BAR; PG8_MMA(0, 0, At, B0); PG8_MMA(0, 1, At, B1); PG8_BAR; PG8_SCHED;
            PG8_LDA(At, 0, 1); PG8_STAGE(PG8_SB(0, 0), b2, voffB); PG8_STAGE(PG8_SB(0, 1), b2 + hstep, voffB); PG8_STAGE(PG8_SA(0, 0), a2, voffA);
            PG8_WAIT_V(8); PG8_WAIT_L(0); PG8_BAR; PG8_MMA(1, 0, At, B0); PG8_MMA(1, 1, At, B1); PG8_BAR; PG8_SCHED;
            PG8_LDB(B0, 1, 0); PG8_LDB(B1, 1, 1); PG8_SCHED; PG8_LDA(At, 1, 0); PG8_STAGE(PG8_SA(0, 1), a2 + hstep, voffA);
            PG8_WAIT_V(8); PG8_WAIT_L(0); PG8_BAR; PG8_MMA(0, 0, At, B0); PG8_MMA(0, 1, At, B1); PG8_BAR; PG8_SCHED;
            PG8_LDA(At, 1, 1); PG8_STAGE(PG8_SB(1, 0), b3, voffB); PG8_STAGE(PG8_SB(1, 1), b3 + hstep, voffB); PG8_STAGE(PG8_SA(1, 0), a3, voffA);
            PG8_WAIT_V(8); PG8_WAIT_L(0); PG8_BAR; PG8_MMA(1, 0, At, B0); PG8_MMA(1, 1, At, B1); PG8_BAR; PG8_SCHED;
            } else {
            PG8_LDB(B0, 0, 0); PG8_SCHED; PG8_LDA(At, 0, 0); PG8_STAGE(PG8_SA(1, 1), a1 + hstep, voffA);
            PG8_WAIT_L(8); PG8_BAR; PG8_WAIT_L(0); PG8_MMA(0, 0, At, B0); PG8_BAR; PG8_SCHED;
            PG8_LDB(B1, 0, 1); PG8_STAGE(PG8_SB(0, 0), b2, voffB);
            PG8_BAR; PG8_WAIT_L(0); PG8_MMA(0, 1, At, B1); PG8_BAR;
            PG8_LDA(At, 0, 1); PG8_STAGE(PG8_SA(0, 0), a2, voffA);
            PG8_BAR; PG8_WAIT_L(0); PG8_MMA(1, 0, At, B0); PG8_BAR; PG8_SCHED;
            PG8_STAGE(PG8_SB(0, 1), b2 + hstep, voffB);
            PG8_WAIT_V(6); PG8_BAR; PG8_MMA(1, 1, At, B1); PG8_BAR;
            PG8_LDB(B0, 1, 0); PG8_SCHED; PG8_LDA(At, 1, 0); PG8_STAGE(PG8_SA(0, 1), a2 + hstep, voffA);
            PG8_WAIT_L(8); PG8_BAR; PG8_WAIT_L(0); PG8_MMA(0, 0, At, B0); PG8_BAR; PG8_SCHED;
            PG8_LDB(B1, 1, 1); PG8_STAGE(PG8_SB(1, 0), b3, voffB);
            PG8_BAR; PG8_WAIT_L(0); PG8_MMA(0, 1, At, B1); PG8_BAR;
            PG8_LDA(At, 1, 1); PG8_STAGE(PG8_SA(1, 0), a3, voffA);
            PG8_BAR; PG8_WAIT_L(0); PG8_MMA(1, 0, At, B0); PG8_BAR; PG8_SCHED;
            PG8_STAGE(PG8_SB(1, 1), b3 + hstep, voffB);
            PG8_WAIT_V(6); PG8_BAR; PG8_MMA(1, 1, At, B1); PG8_BAR;
            }
        }
        if constexpr (ALIGN_EPI) { if (wr == 0) PG8_BAR; }
        if constexpr (!Epi::AFTER_DRAIN) { E(acc, cur, wr, wc, fr, fq, rsc); S.done(cur); }
        if (!has_next) break;
#pragma unroll
        for (int a = 0; a < 2; ++a)
#pragma unroll
            for (int b = 0; b < 2; ++b)
#pragma unroll
                for (int m = 0; m < 4; ++m)
#pragma unroll
                    for (int n = 0; n < 2; ++n) acc[a][b][m][n] = (f32x4){0.f, 0.f, 0.f, 0.f};
        cur = nxt; cA = nA; cB = nB; ++ui;
        if constexpr (ALIGN_EPI) { if (wr == 1) PG8_BAR; }
    }
    PG8_WAIT_V(0);
    if constexpr (!ALIGN_EPI) { if (wr == 0) PG8_BAR; }
    PG8_BAR;
    if constexpr (Epi::AFTER_DRAIN) { E.fused(acc, cur, wr, wc, fr, fq, lds, wid, lane); S.done(cur); }
#undef PG8_SA
#undef PG8_SB
#undef PG8_STAGE
#undef PG8_LDA
#undef PG8_LDB
#undef PG8_MMA
#undef PG8_WAIT_V
#undef PG8_WAIT_L
#undef PG8_BAR
#undef PG8_SCHED
}
}


#define XB_TMO      128
#define XB_XCNT(j)  (256  + 64 * (j))
#define XB_XSUB(j)  (1280 + 64 * (j))
#define XB_XGEN(j)  (2304 + 64 * (j))
#define XB_TOP      3328
#define XB_TOPGEN   3392
#define XCD_BAR_WORDS 3456
#define XB_SPIN_CAP (1u << 18)
__device__ __forceinline__ unsigned xb_ld(unsigned* p)              { return __hip_atomic_load(p, __ATOMIC_RELAXED, __HIP_MEMORY_SCOPE_AGENT); }
__device__ __forceinline__ unsigned xb_add(unsigned* p, unsigned v) { return __hip_atomic_fetch_add(p, v, __ATOMIC_RELAXED, __HIP_MEMORY_SCOPE_AGENT); }
__device__ __forceinline__ unsigned xb_xcc_id() { return (unsigned)__builtin_amdgcn_s_getreg((3 << 11) | 20) & 0xFu; }
#define XB_SPIN(cond, bar) do { unsigned _sp = 0; while (cond) { __builtin_amdgcn_s_sleep(1); \
    if ((++_sp & 255u) == 0u) { if (xb_ld(&(bar)[XB_TMO])) break; if (_sp > XB_SPIN_CAP) { atomicAdd(&(bar)[XB_TMO], 1u); break; } } } } while (0)
struct XcdBarrier { unsigned* bar; unsigned x; volatile LAS unsigned* st; };
__device__ __forceinline__ XcdBarrier xcd_barrier_post(unsigned* bar, volatile LAS unsigned* st) {
    XcdBarrier b; b.bar = bar; b.x = xb_xcc_id(); b.st = st;
    if (threadIdx.x == 0) (void)xb_add(&bar[XB_XCNT(b.x)], 1u);
    return b;
}
__device__ __forceinline__ void xcd_barrier_complete(unsigned* bar, unsigned x, unsigned& nloc, unsigned& nx) {
    const unsigned G = gridDim.x * gridDim.y * gridDim.z;
    unsigned sum, cnt, mine, sp = 0u;
    for (;;) {
        sum = 0u; cnt = 0u; mine = 0u;
#pragma unroll
        for (unsigned j = 0; j < 16; ++j) { const unsigned c = xb_ld(&bar[XB_XCNT(j)]); sum += c; cnt += (c > 0u) ? 1u : 0u; mine = (j == x) ? c : mine; }
        if (sum == G) break;
        __builtin_amdgcn_s_sleep(1);
        if ((++sp & 255u) == 0u) { if (xb_ld(&bar[XB_TMO])) break; if (sp > XB_SPIN_CAP) { atomicAdd(&bar[XB_TMO], 1u); break; } }
    }
    nloc = mine > 0u ? mine : 1u; nx = cnt > 0u ? cnt : 1u;
}
__device__ __forceinline__ void xcd_barrier(const XcdBarrier& b) {
    asm volatile("s_waitcnt vmcnt(0)" ::: "memory");
    __syncthreads();
    if (threadIdx.x == 0) {
        unsigned* bar = b.bar;
        __builtin_amdgcn_s_waitcnt(0);
        unsigned nloc = b.st[0], nx = b.st[1];
        if (nloc == 0u) { xcd_barrier_complete(bar, b.x, nloc, nx); b.st[0] = nloc; b.st[1] = nx; }
        const unsigned old = xb_add(&bar[XB_XSUB(b.x)], 1u);
        const unsigned gen = old / nloc;
        if (old + 1u == (gen + 1u) * nloc) {
            __builtin_amdgcn_fence(__ATOMIC_RELEASE, "agent");
            asm volatile("s_waitcnt vmcnt(0)" ::: "memory");
            const unsigned og = xb_add(&bar[XB_TOP], 1u);
            const unsigned tg = og / nx;
            if (og + 1u == (tg + 1u) * nx) xb_add(&bar[XB_TOPGEN], 1u);
            else XB_SPIN(xb_ld(&bar[XB_TOPGEN]) == tg, bar);
            __builtin_amdgcn_fence(__ATOMIC_ACQUIRE, "agent");
            xb_add(&bar[XB_XGEN(b.x)], 1u);
            asm volatile("s_waitcnt vmcnt(0)" ::: "memory");
        } else {
            XB_SPIN(xb_ld(&bar[XB_XGEN(b.x)]) == gen, bar);
            __builtin_amdgcn_fence(__ATOMIC_ACQUIRE, "agent");
            asm volatile("s_waitcnt vmcnt(0)" ::: "memory");
        }
    }
    __syncthreads();
}

constexpr int DM = 1024, NBATCH = 16, SEQ = 2048, MPR = NBATCH * SEQ, DBATCH = 128, MREAL = MPR + DBATCH, MPAD = 33024;
constexpr int DIN = 5632, DFF = 4096, NHEAD = 16;
constexpr int C_Q = 0, C_K = 1024, C_V = 1280, C_U = 1536, C_G = 2560, C_GA = 3584, C_GR = 4608;
constexpr float EPS = 1e-6f;
constexpr size_t O_YP = 0, O_YS = 33554432, O_KWP = 33685504, O_VWP = 34209792, O_CP = 34734080, O_LP = 34783232,
                 O_KWS = 34799616, O_VWS = 38993920, O_CS = 43188224, O_LS = 43581440;
constexpr size_t MiB = 1u << 20;
constexpr size_t WS_WIN = MiB / 2, WS_WOUT = WS_WIN + 11 * MiB, WS_WUP = WS_WOUT + 2 * MiB, WS_WDN = WS_WUP + 8 * MiB;
constexpr size_t ROWB = (size_t)DM * 2;
constexpr size_t WS_XS = WS_WDN + 8 * MiB;
constexpr size_t WS_A = WS_XS + (size_t)MREAL * ROWB;
constexpr size_t WS_B = WS_A + (size_t)MREAL * ROWB;
constexpr size_t WS_PEAK = WS_B + (size_t)MREAL * DIN * 2;
constexpr size_t WS_H = WS_XS;
constexpr size_t WS_HN = 287 * MiB;
constexpr size_t WS_X1 = 352 * MiB;
constexpr size_t WS_MIXS = 416 * MiB;
constexpr size_t WS_RS2 = WS_MIXS + MiB / 2;
constexpr size_t WS_NEED = WS_PEAK;
static_assert(WS_H + (size_t)MREAL * DFF * 2 <= WS_HN && WS_HN + (size_t)MREAL * ROWB <= WS_X1 && WS_X1 + (size_t)MPR * ROWB <= WS_MIXS && WS_MIXS + 3 * MiB <= WS_PEAK && WS_B <= WS_HN, "d_ws map");
static_assert(WS_PEAK <= 512 * MiB, "fits the 512 MiB workspace");

constexpr int NWAVES = 8;
constexpr int LDS_BYTES = 147456;
constexpr int L_K = 0, L_VT = 36864, L_UC = 73728, L_WT = 108544, L_PAR = 126976, L_SEG = 129024, L_CAR = 133120, L_SMP = 133632;
constexpr int KST = 72, UST = 68;
constexpr int L_MISC = 147392;
static_assert(L_SMP + 8 * 1024 <= L_MISC && L_MISC + 8 <= LDS_BYTES, "LDS map");
constexpr size_t CTL_BYTES = 131072;
constexpr size_t WS_CNT = 16384, CNT_BANK = 128 * 64 * 4;
constexpr size_t WS_FLAG = WS_CNT + 3 * CNT_BANK;
constexpr size_t WS_RS = 262144;

struct Args { const float* in[22]; float* out; unsigned char* ws; };
enum { I_XP = 0, I_XS, I_CK, I_CV, I_SC, I_SL, I_WIN, I_WOUT, I_SINK, I_CW, I_CB, I_WA, I_BA, I_WX, I_BX, I_LAM, I_WUP, I_WDN, I_GPM, I_GQM, I_GPF, I_GQF };

__device__ __forceinline__ void p0_transpose_item(const float* W, int K, int N, bf16* WT, LAS float* scr, int item, int lane, const float* gk = nullptr) {
    const int nblk = N / 32, kb = item / nblk, nb = item % nblk, k0 = 64 * kb, n0 = 32 * nb;
    float wv[32];
#pragma unroll
    for (int i = 0; i < 32; ++i) { const int kk = 2 * i + (lane >> 5); wv[i] = W[(size_t)(k0 + kk) * N + n0 + (lane & 31)]; }
    if (gk) {
#pragma unroll
        for (int i = 0; i < 32; ++i) wv[i] *= gk[k0 + 2 * i + (lane >> 5)]; }
#pragma unroll
    for (int i = 0; i < 32; ++i) { const int kk = 2 * i + (lane >> 5); scr[kk * 33 + (lane & 31)] = wv[i]; }
    asm volatile("s_waitcnt lgkmcnt(0)" ::: "memory");
    const int c = lane & 7;
#pragma unroll
    for (int j = 0; j < 4; ++j) { const int n = (lane >> 3) + 8 * j; const LAS float* s = scr + (8 * c) * 33 + n;
        v4u o; o.x = pk2(s[0 * 33], s[1 * 33]); o.y = pk2(s[2 * 33], s[3 * 33]); o.z = pk2(s[4 * 33], s[5 * 33]); o.w = pk2(s[6 * 33], s[7 * 33]);
        *(v4u*)(WT + (size_t)(n0 + n) * K + k0 + 8 * c) = o; }
    asm volatile("s_waitcnt lgkmcnt(0)" ::: "memory");
}
__device__ __forceinline__ void rows2_to_bf16(const float* xa, const float* xb, bool has_b, bf16* oa, bf16* ob, float* rsa_out, float* rsb_out, int lane) {
    const f32x4* ra = (const f32x4*)xa + lane; const f32x4* rb = (const f32x4*)xb + lane;
    f32x4 va[4], vb[4]; float sa = 0.f, sb = 0.f;
#pragma unroll
    for (int j = 0; j < 4; ++j) { va[j] = ra[64 * j]; vb[j] = has_b ? rb[64 * j] : (f32x4){0.f, 0.f, 0.f, 0.f}; }
#pragma unroll
    for (int j = 0; j < 4; ++j) { sa += (va[j].x * va[j].x + va[j].y * va[j].y) + (va[j].z * va[j].z + va[j].w * va[j].w); sb += (vb[j].x * vb[j].x + vb[j].y * vb[j].y) + (vb[j].z * vb[j].z + vb[j].w * vb[j].w); }
#pragma unroll
    for (int o = 1; o < 64; o <<= 1) { sa += __shfl_xor(sa, o); sb += __shfl_xor(sb, o); }
    const float rsa = 1.0f / sqrtf(sa * (1.f / DM) + EPS), rsb = 1.0f / sqrtf(sb * (1.f / DM) + EPS);
    unsigned long long* o8a = (unsigned long long*)oa + lane; unsigned long long* o8b = (unsigned long long*)ob + lane;
#pragma unroll
    for (int j = 0; j < 4; ++j) { const f32x4 pa = va[j] * rsa, pb = vb[j] * rsb;
        o8a[64 * j] = (unsigned long long)pk2(pa.x, pa.y) | ((unsigned long long)pk2(pa.z, pa.w) << 32);
        if (has_b) o8b[64 * j] = (unsigned long long)pk2(pb.x, pb.y) | ((unsigned long long)pk2(pb.z, pb.w) << 32); }
    if (lane == 0) { *rsa_out = rsa; if (has_b) *rsb_out = rsb; }
}
__device__ __forceinline__ void p0_prologue(const Args& A, LAS unsigned char* lds, int G) {
    const int tid = opaque_tid(), lane = tid & 63, wave = __builtin_amdgcn_readfirstlane(tid >> 6);
    LAS float* scr = (LAS float*)(lds + wave * 16384);
    const int gw = blockIdx.x * NWAVES + wave, NGW = G * NWAVES;
    constexpr int I_1 = (DM / 64) * (DIN / 32), I_2 = (DM / 64) * (DM / 32), I_3 = (DM / 64) * (DFF / 32), I_4 = (DFF / 64) * (DM / 32);
    constexpr int NITEMS = I_1 + I_2 + I_3 + I_4;
    for (int it = gw; it < NITEMS; it += NGW) {
        int r = it;
        if (r < I_1) { p0_transpose_item(A.in[I_WIN], DM, DIN, (bf16*)(A.ws + WS_WIN), scr, r, lane, A.in[I_GPM]); continue; } r -= I_1;
        if (r < I_2) { p0_transpose_item(A.in[I_WOUT], DM, DM, (bf16*)(A.ws + WS_WOUT), scr, r, lane); continue; } r -= I_2;
        if (r < I_3) { p0_transpose_item(A.in[I_WUP], DM, DFF, (bf16*)(A.ws + WS_WUP), scr, r, lane, A.in[I_GPF]); continue; } r -= I_3;
        p0_transpose_item(A.in[I_WDN], DFF, DM, (bf16*)(A.ws + WS_WDN), scr, r, lane);
    }
    { const f32x4* ck = (const f32x4*)A.in[I_CK]; const f32x4* cv = (const f32x4*)A.in[I_CV]; f32x4* ok = (f32x4*)(A.out + O_KWS); f32x4* ov = (f32x4*)(A.out + O_VWS);
      const int NT = G * NWAVES * 64;
#pragma unroll 4
      for (int i = gw * 64 + lane; i < DBATCH * 127 * 64; i += NT) { const int bs = i / (127 * 64), r = i - bs * (127 * 64);
          ok[(size_t)bs * 8192 + r] = ck[(size_t)bs * 8192 + 64 + r]; ov[(size_t)bs * 8192 + r] = cv[(size_t)bs * 8192 + 64 + r]; } }
    bf16* XN = (bf16*)(A.ws + WS_XS);
    for (int m = gw; m < MREAL; m += 4 * NGW) {
        constexpr int NR = 4; f32x4 v[NR][4]; float ss[NR]; int mr[NR]; bool ok[NR];
#pragma unroll
        for (int r = 0; r < NR; ++r) { const int mm = m + r * NGW; ok[r] = mm < MREAL; mr[r] = ok[r] ? mm : m;
            const f32x4* src = (const f32x4*)((mr[r] < MPR) ? A.in[I_XP] + (size_t)mr[r] * DM : A.in[I_XS] + (size_t)(mr[r] - MPR) * DM) + lane;
#pragma unroll
            for (int j = 0; j < 4; ++j) v[r][j] = src[64 * j]; }
#pragma unroll
        for (int r = 0; r < NR; ++r) { float a = 0.f;
#pragma unroll
            for (int j = 0; j < 4; ++j) a += (v[r][j].x * v[r][j].x + v[r][j].y * v[r][j].y) + (v[r][j].z * v[r][j].z + v[r][j].w * v[r][j].w);
            ss[r] = a; }
#pragma unroll
        for (int o = 1; o < 64; o <<= 1) {
#pragma unroll
            for (int r = 0; r < NR; ++r) ss[r] += __shfl_xor(ss[r], o); }
#pragma unroll
        for (int r = 0; r < NR; ++r) { const float rs = 1.0f / sqrtf(ss[r] * (1.f / DM) + EPS);
            if (ok[r]) { unsigned long long* o8 = (unsigned long long*)(XN + (size_t)mr[r] * DM) + lane;
#pragma unroll
                for (int j = 0; j < 4; ++j) { const f32x4 p = v[r][j] * rs; o8[64 * j] = (unsigned long long)pk2(p.x, p.y) | ((unsigned long long)pk2(p.z, p.w) << 32); }
                if (lane == 0) ((float*)(A.ws + WS_RS))[mr[r]] = rs; } }
    }
}

#define MFMA16(a, b, c) __builtin_amdgcn_mfma_f32_16x16x32_bf16((a), (b), (c), 0, 0, 0)
#define LDS_FENCE() asm volatile("s_waitcnt lgkmcnt(0)" ::: "memory")

struct P2Regs { v4u k[2], v[2], u[5]; };
struct P2Cur { bf16x8 q[2]; v2u ga[4], gr[4], gb[4]; };
struct P2Off { unsigned k[2], v[2], u, q, gt; };
#define RAW_BARRIER() do { asm volatile("s_waitcnt lgkmcnt(0)" ::: "memory"); __builtin_amdgcn_s_barrier(); asm volatile("" ::: "memory"); } while (0)

__device__ __forceinline__ void p2_issue(const char* zc, const P2Off& O, P2Regs& R) {
#pragma unroll
    for (int it = 0; it < 2; ++it) R.k[it] = *(const v4u*)(zc + O.k[it]);
#pragma unroll
    for (int it = 0; it < 2; ++it) R.v[it] = *(const v4u*)(zc + O.v[it]);
}
__device__ __forceinline__ void p2_issue_u(const char* zc, const P2Off& O, P2Regs& R) {
#pragma unroll
    for (int i = 0; i < 5; ++i) R.u[i] = *(const v4u*)(zc + (long)(i - 3) * (DIN * 2) + O.u);
}
__device__ __forceinline__ void p2_issue_q(const char* zc, const P2Off& O, P2Cur& Q) {
    Q.q[0] = *(const bf16x8*)(zc + O.q); Q.q[1] = *(const bf16x8*)(zc + O.q + 64);
}
__device__ __forceinline__ void p2_issue_gates(const char* zc, const P2Off& O, P2Cur& Q) {
#pragma unroll
    for (int nt = 0; nt < 4; ++nt) {
        Q.ga[nt] = *(const v2u*)(zc + O.gt + 32 * nt); Q.gr[nt] = *(const v2u*)(zc + O.gt + 32 * nt + (C_GR - C_GA) * 2); Q.gb[nt] = *(const v2u*)(zc + (O.gt + 32 * nt - (unsigned)((C_GA - C_G) * 2))); }
}
__device__ __forceinline__ v2u merge4(v2u gav, v2u grv, v2u gbv, f32x4 o, f32x4 h) {
    constexpr float L2E = 1.4426950408889634f;
    const f32x4 ga = (f32x4){bflo(gav.x), bfhi(gav.x), bflo(gav.y), bfhi(gav.y)}, gr = (f32x4){bflo(grv.x), bfhi(grv.x), bflo(grv.y), bfhi(grv.y)}, gb = (f32x4){bflo(gbv.x), bfhi(gbv.x), bflo(gbv.y), bfhi(gbv.y)};
    const f32x4 xa = ga * (-L2E), xr = gr * (-L2E), xg = gb * (gb * gb * (-0.044715f * 1.5957691216057308f * L2E) + (-1.5957691216057308f * L2E));
    f32x4 ea, er, eg;
#pragma unroll
    for (int j = 0; j < 4; ++j) { ea[j] = __builtin_amdgcn_exp2f(xa[j]); er[j] = __builtin_amdgcn_exp2f(xr[j]); eg[j] = __builtin_amdgcn_exp2f(xg[j]); }
    const f32x4 da = ea + 1.0f, dr = (er + 1.0f) * (eg + 1.0f);
    f32x4 ra, rr;
#pragma unroll
    for (int j = 0; j < 4; ++j) { ra[j] = __builtin_amdgcn_rcpf(da[j]); rr[j] = __builtin_amdgcn_rcpf(dr[j]); }
    const f32x4 m = o * ra + gb * h * rr;
    return (v2u){pk2(m[0], m[1]), pk2(m[2], m[3])};
}
__device__ __forceinline__ P2Off p2_make_off(int tid, int wave, int n) {
    const int lane = tid & 63, g = lane >> 4, lq = lane & 15, kvh = n >> 2;
    P2Off O;
#pragma unroll
    for (int it = 0; it < 2; ++it) { const int i = tid + 512 * it, key = i >> 3, dg = i & 7; O.k[it] = (unsigned)(key * DIN + C_K + 64 * kvh + 8 * dg) * 2u; }
#pragma unroll
    for (int it = 0; it < 2; ++it) { const int i = tid + 512 * it, key = i >> 3, dg = i & 7; O.v[it] = (unsigned)(key * DIN + C_V + 64 * kvh + 8 * dg) * 2u; }
    const int ct0 = 16 * wave + 2 * (lane >> 3);
    O.u = (unsigned)(ct0 * DIN + C_U + 64 * n + 8 * (lane & 7)) * 2u;
    O.q = (unsigned)((16 * wave + lq) * DIN + 64 * n + C_Q + 8 * g) * 2u;
    O.gt = (unsigned)((16 * wave + lq) * DIN + 64 * n + C_GA + 4 * g) * 2u;
    return O;
}
__device__ __forceinline__ void p2_prompt_unit(const Args& A, LAS unsigned char* lds, int b, int n) {
    const int tid0 = opaque_tid();
    const int wave = __builtin_amdgcn_readfirstlane(tid0 >> 6);
    const int kvh = n >> 2;
    const bf16* Z = (const bf16*)(A.ws + WS_B);
    bf16* MG = (bf16*)(A.ws + WS_A);
    float* out = A.out;
    LAS bf16* Kl = (LAS bf16*)(lds + L_K); LAS bf16* Vt = (LAS bf16*)(lds + L_VT); LAS float* UC = (LAS float*)(lds + L_UC);
    LAS bf16* WT = (LAS bf16*)(lds + L_WT); LAS float* PAR = (LAS float*)(lds + L_PAR); LAS float* SEG = (LAS float*)(lds + L_SEG); LAS float* CAR = (LAS float*)(lds + L_CAR);
    const char* zu = (const char*)Z + (size_t)b * SEQ * DIN * 2;
    P2Regs R;
    { const int tid = tid0; const P2Off O = p2_make_off(tid, wave, n);
    p2_issue(zu, O, R); p2_issue_u(zu, O, R);
    if (tid < 64) { const int ch = 64 * n + tid;
#pragma unroll
        for (int i = 0; i < 4; ++i) PAR[i * 64 + tid] = A.in[I_CW][i * DM + ch];
        PAR[4 * 64 + tid] = A.in[I_CB][ch]; PAR[5 * 64 + tid] = -1.4426950408889634f * A.in[I_BA][ch]; PAR[6 * 64 + tid] = -1.4426950408889634f * A.in[I_BX][ch];
        PAR[7 * 64 + tid] = -8.0f * 1.4426950408889634f * log1pf(expf(-A.in[I_LAM][ch]));
        CAR[tid] = 0.f; CAR[64 + tid] = 0.f; }
    { const int c = tid >> 3, dg = tid & 7; const float* wa = A.in[I_WA] + (size_t)n * 4096 + c * 64 + 8 * dg; const float* wx = A.in[I_WX] + (size_t)n * 4096 + c * 64 + 8 * dg;
#pragma unroll
        for (int e = 0; e < 8; ++e) { WT[(8 * dg + e) * KST + c] = f2bf(wa[e]); WT[64 * KST + (8 * dg + e) * KST + c] = f2bf(wx[e]); } }
    for (int i = tid; i < 128 * KST * 2 / 16; i += 512) *(LAS v4u*)((LAS unsigned char*)Kl + 128 * KST * 2 + i * 16) = (v4u){0u, 0u, 0u, 0u};
    for (int i = tid; i < 128 * KST * 2 / 16; i += 512) *(LAS v4u*)((LAS unsigned char*)Vt + 128 * KST * 2 + i * 16) = (v4u){0u, 0u, 0u, 0u};
    RAW_BARRIER(); }
    const float sink = A.in[I_SINK][n];

    for (int c = 0; c < 16; ++c) {
        int tid = tid0; asm volatile("" : "+v"(tid));
        const int lane = tid & 63, g = lane >> 4, lq = lane & 15, ct0 = 16 * wave + 2 * (lane >> 3);
        const P2Off O = p2_make_off(tid, wave, n);
        const int m0 = b * SEQ + c * 128, hc = c & 1, hp = hc ^ 1;
        const char* zc = zu + (size_t)c * 128 * DIN * 2;
        P2Cur Q; p2_issue_q(zc, O, Q);
#pragma unroll
        for (int it = 0; it < 2; ++it) { const int i = tid + 512 * it, key = i >> 3, dg = i & 7;
            const v4u kv = R.k[it];
            *(LAS v4u*)(Kl + (hc * 128 + key) * KST + 8 * dg) = kv; }
#pragma unroll
        for (int it = 0; it < 2; ++it) { const int i = tid + 512 * it, key = i >> 3, dg = i & 7;
            *(LAS v4u*)(Vt + (hc * 128 + key) * KST + 8 * dg) = R.v[it]; }

        { const int tp = lane >> 3, c8 = 8 * (lane & 7), t0 = 16 * wave + 2 * tp;
          float a0[8], a1[8];
          { const f32x4 b0 = *(LAS f32x4*)(PAR + 4 * 64 + c8), b1 = *(LAS f32x4*)(PAR + 4 * 64 + c8 + 4);
            a0[0] = b0.x; a0[1] = b0.y; a0[2] = b0.z; a0[3] = b0.w; a0[4] = b1.x; a0[5] = b1.y; a0[6] = b1.z; a0[7] = b1.w;
#pragma unroll
            for (int e = 0; e < 8; ++e) a1[e] = a0[e]; }
#pragma unroll
          for (int i = 0; i < 5; ++i) { v4u uv = R.u[i];
              if (c == 0 && t0 - 3 + i < 0) uv = (v4u){0u, 0u, 0u, 0u};
              const float uf[8] = {bflo(uv.x), bfhi(uv.x), bflo(uv.y), bfhi(uv.y), bflo(uv.z), bfhi(uv.z), bflo(uv.w), bfhi(uv.w)};
              if (i < 4) { const f32x4 w0 = *(LAS f32x4*)(PAR + i * 64 + c8), w1 = *(LAS f32x4*)(PAR + i * 64 + c8 + 4);
                  const float wv[8] = {w0.x, w0.y, w0.z, w0.w, w1.x, w1.y, w1.z, w1.w};
#pragma unroll
                  for (int e = 0; e < 8; ++e) a0[e] += wv[e] * uf[e]; }
              if (i > 0) { const f32x4 w0 = *(LAS f32x4*)(PAR + (i - 1) * 64 + c8), w1 = *(LAS f32x4*)(PAR + (i - 1) * 64 + c8 + 4);
                  const float wv[8] = {w0.x, w0.y, w0.z, w0.w, w1.x, w1.y, w1.z, w1.w};
#pragma unroll
                  for (int e = 0; e < 8; ++e) a1[e] += wv[e] * uf[e]; } }
          *(LAS f32x4*)(UC + t0 * UST + c8) = (f32x4){a0[0], a0[1], a0[2], a0[3]}; *(LAS f32x4*)(UC + t0 * UST + c8 + 4) = (f32x4){a0[4], a0[5], a0[6], a0[7]};
          *(LAS f32x4*)(UC + (t0 + 1) * UST + c8) = (f32x4){a1[0], a1[1], a1[2], a1[3]}; *(LAS f32x4*)(UC + (t0 + 1) * UST + c8 + 4) = (f32x4){a1[4], a1[5], a1[6], a1[7]}; }
        p2_issue(zc + (size_t)128 * DIN * 2, O, R);
        LDS_FENCE();
        f32x4 ga[4], gx[4];
#pragma unroll
        for (int nt = 0; nt < 4; ++nt) { ga[nt] = (f32x4){0.f, 0.f, 0.f, 0.f}; gx[nt] = (f32x4){0.f, 0.f, 0.f, 0.f}; }
#pragma unroll
        for (int ks = 0; ks < 2; ++ks) {
            const f32x4 u0 = *(LAS f32x4*)(UC + (16 * wave + lq) * UST + 32 * ks + 8 * g), u1 = *(LAS f32x4*)(UC + (16 * wave + lq) * UST + 32 * ks + 8 * g + 4);
            v4u ap; ap.x = pk2(u0.x, u0.y); ap.y = pk2(u0.z, u0.w); ap.z = pk2(u1.x, u1.y); ap.w = pk2(u1.z, u1.w);
            const bf16x8 af = __builtin_bit_cast(bf16x8, ap);
#pragma unroll
            for (int nt = 0; nt < 4; ++nt) {
                const bf16x8 ba = *(LAS bf16x8*)(WT + (16 * nt + lq) * KST + 32 * ks + 8 * g);
                const bf16x8 bx = *(LAS bf16x8*)(WT + 64 * KST + (16 * nt + lq) * KST + 32 * ks + 8 * g);
                ga[nt] = MFMA16(af, ba, ga[nt]); gx[nt] = MFMA16(af, bx, gx[nt]); } }
        float av[4][4], PA[4], PB[4];
#pragma unroll
        for (int nt = 0; nt < 4; ++nt) { const int ch = 16 * nt + lq;
            const float nba = PAR[5 * 64 + ch], nbx = PAR[6 * 64 + ch], spc = PAR[7 * 64 + ch];
            const f32x4 ea4 = ga[nt] * (-1.4426950408889634f) + nba, ex4 = gx[nt] * (-1.4426950408889634f) + nbx;
            f32x4 r4, i4, a4, m4, u4;
#pragma unroll
            for (int j = 0; j < 4; ++j) { r4[j] = __builtin_amdgcn_rcpf(1.0f + __builtin_amdgcn_exp2f(ea4[j])); i4[j] = __builtin_amdgcn_rcpf(1.0f + __builtin_amdgcn_exp2f(ex4[j]));
                u4[j] = UC[(16 * wave + 4 * g + j) * UST + ch]; }
            const f32x4 la4 = r4 * spc;
#pragma unroll
            for (int j = 0; j < 4; ++j) a4[j] = __builtin_amdgcn_exp2f(la4[j]);
            const f32x4 om = 1.0f - a4 * a4;
#pragma unroll
            for (int j = 0; j < 4; ++j) m4[j] = __builtin_amdgcn_sqrtf(om[j]);
            if (c == 0 && wave == 0 && g == 0) m4[0] = 1.0f;
            const f32x4 b4 = m4 * i4 * u4;
            float Aq = 1.f, Bq = 0.f;
#pragma unroll
            for (int j = 0; j < 4; ++j) { av[nt][j] = a4[j]; UC[(16 * wave + 4 * g + j) * UST + ch] = b4[j]; Bq = a4[j] * Bq + b4[j]; Aq = Aq * a4[j]; }
            float pa = 1.f, pb = 0.f, wa_ = 1.f, wb_ = 0.f;
#pragma unroll
            for (int k = 0; k < 4; ++k) { const float Ak = __shfl(Aq, lq + 16 * k), Bk = __shfl(Bq, lq + 16 * k);
                if (k < g) { pb = Ak * pb + Bk; pa = pa * Ak; }
                wb_ = Ak * wb_ + Bk; wa_ = wa_ * Ak; }
            PA[nt] = pa; PB[nt] = pb;
            if (g == 0) { SEG[wave * 64 + ch] = wa_; SEG[512 + wave * 64 + ch] = wb_; } }
        RAW_BARRIER();
        p2_issue_gates(zc, O, Q);
        p2_issue_u(zc + (size_t)128 * DIN * 2, O, R);
#pragma unroll
        for (int nt = 0; nt < 4; ++nt) { const int ch = 16 * nt + lq;
            float h = CAR[hc * 64 + ch];
#pragma unroll
            for (int w2 = 0; w2 < 7; ++w2) { const float sa = SEG[w2 * 64 + ch], sb = SEG[512 + w2 * 64 + ch]; h = (w2 < wave) ? sa * h + sb : h; }
            h = PA[nt] * h + PB[nt];
#pragma unroll
            for (int j = 0; j < 4; ++j) { const int t = 16 * wave + 4 * g + j; h = av[nt][j] * h + UC[t * UST + ch]; UC[t * UST + ch] = h; }
            if (wave == 7 && g == 3) CAR[hp * 64 + ch] = h; }
        LDS_FENCE();
        {
            f32x4 sT[9];
#pragma unroll
            for (int jt = 0; jt < 9; ++jt) { const int kt = wave + jt; const int base = ((kt < 8) ? hp : hc) * 128 + (kt & 7) * 16;
                const LAS bf16* kp = Kl + (base + lq) * KST + 8 * g;
                const bf16x8 k0 = *(const LAS bf16x8*)kp, k1 = *(const LAS bf16x8*)(kp + 32);
                f32x4 acc = (f32x4){0.f, 0.f, 0.f, 0.f};
                acc = MFMA16(k0, Q.q[0], acc); acc = MFMA16(k1, Q.q[1], acc); sT[jt] = acc;
                }
            const int qi = 16 * wave + lq;
            float mx = -INFINITY;
#pragma unroll
            for (int jt = 0; jt < 9; ++jt)
#pragma unroll
                for (int j = 0; j < 4; ++j) { const int kj = 16 * (wave + jt) + 4 * g + j;
                    bool valid = (c > 0 || kj >= 128);
                    if (jt == 0) valid = valid && (kj >= qi);
                    if (jt == 8) valid = valid && (kj <= qi + 128);
                    const float sv = valid ? sT[jt][j] : -INFINITY; sT[jt][j] = sv; mx = fmaxf(mx, sv); }
            mx = fmaxf(mx, __shfl_xor(mx, 16)); mx = fmaxf(mx, __shfl_xor(mx, 32));
            constexpr float SC = 0.125f * 1.4426950408889634f;
            const float mxl = fmaxf(mx * SC, sink * 1.4426950408889634f);
            f32x4 sum4 = (f32x4){0.f, 0.f, 0.f, 0.f};
#pragma unroll
            for (int jt = 0; jt < 9; ++jt) { const f32x4 e4 = sT[jt] * SC - mxl; f32x4 p4;
#pragma unroll
                for (int j = 0; j < 4; ++j) p4[j] = __builtin_amdgcn_exp2f(e4[j]);
                sT[jt] = p4; sum4 += p4; }
            float sum = (sum4[0] + sum4[1]) + (sum4[2] + sum4[3]);
            sum += __shfl_xor(sum, 16); sum += __shfl_xor(sum, 32);
            const float inv = __builtin_amdgcn_rcpf(sum + __builtin_amdgcn_exp2f(sink * 1.4426950408889634f - mxl));
            f32x4 oT[4];
#pragma unroll
            for (int nt = 0; nt < 4; ++nt) oT[nt] = (f32x4){0.f, 0.f, 0.f, 0.f};
#pragma unroll
            for (int kk = 0; kk < 5; ++kk) { const int jt0 = 2 * kk, jt1 = (2 * kk + 1 < 9) ? 2 * kk + 1 : 8;
                v4u pp; pp.x = pk2(sT[jt0][0], sT[jt0][1]); pp.y = pk2(sT[jt0][2], sT[jt0][3]);
                if (kk < 4) { pp.z = pk2(sT[jt1][0], sT[jt1][1]); pp.w = pk2(sT[jt1][2], sT[jt1][3]); } else { pp.z = 0u; pp.w = 0u; }
                const bf16x8 pf = __builtin_bit_cast(bf16x8, pp);
                const int kt0 = wave + jt0; int kt1 = wave + 2 * kk + 1; kt1 = kt1 > 15 ? 15 : kt1;
                const int base0 = ((kt0 < 8) ? hp : hc) * 128 + (kt0 & 7) * 16, base1 = ((kt1 < 8) ? hp : hc) * 128 + (kt1 & 7) * 16;
#pragma unroll
                for (int nt = 0; nt < 4; ++nt) { const LAS bf16* vp = Vt + (4 * g + (lq >> 2)) * KST + 16 * nt + 4 * (lq & 3);
                    const s16x4 t0 = __builtin_amdgcn_ds_read_tr16_b64_v4i16((LAS s16x4*)(vp + base0 * KST)), t1 = __builtin_amdgcn_ds_read_tr16_b64_v4i16((LAS s16x4*)(vp + base1 * KST));
                    const v2u v0 = __builtin_bit_cast(v2u, t0), v1 = __builtin_bit_cast(v2u, t1);
                    const v4u vv = (v4u){v0.x, v0.y, v1.x, v1.y};
                    oT[nt] = MFMA16(__builtin_bit_cast(bf16x8, vv), pf, oT[nt]); } }
            const size_t row = (size_t)(m0 + 16 * wave + lq);
#pragma unroll
            for (int nt = 0; nt < 4; ++nt) { const int d0 = 16 * nt + 4 * g;
                const v2u gav = Q.ga[nt], grv = Q.gr[nt], gbv = Q.gb[nt];
                const f32x4 h4 = *(LAS f32x4*)(UC + (16 * wave + lq) * UST + d0);
                *(v2u*)(MG + row * DM + 64 * n + d0) = merge4(gav, grv, gbv, oT[nt] * inv, h4); }
        }
        RAW_BARRIER();
    }
    { const int mL = b * SEQ + 15 * 128; int tq = tid0; asm volatile("" : "+v"(tq));
      if (tq < 64) out[O_LP + (size_t)b * DM + 64 * n + tq] = CAR[tq];
      if (tq < 192) { const int j = tq >> 6, ch = tq & 63;
          out[O_CP + (size_t)(b * 3 + j) * DM + 64 * n + ch] = bf2f(Z[(size_t)(mL + 125 + j) * DIN + C_U + 64 * n + ch]); }
      {
          { const int i = tq; const int which = i >> 8, key = 32 * (n & 3) + ((i >> 3) & 31), dg = i & 7;
              const v4u kv = *(const v4u*)(Z + (size_t)(mL + key) * DIN + (which ? C_V : C_K) + 64 * kvh + 8 * dg);
              float* o = out + (which ? O_VWP : O_KWP) + ((size_t)(b * 128 + key) * 4 + kvh) * 64 + 8 * dg;
              *(f32x4*)o = (f32x4){bflo(kv.x), bfhi(kv.x), bflo(kv.y), bfhi(kv.y)}; *(f32x4*)(o + 4) = (f32x4){bflo(kv.z), bfhi(kv.z), bflo(kv.w), bfhi(kv.w)}; } }
      RAW_BARRIER(); }
}

__device__ __forceinline__ void p2_sample_item(const Args& A, LAS float* scr, int bs, int n, int lane) {
    const int kvh = n >> 2, cg_ = 64 * n + lane;
    const size_t row = (size_t)MPR + bs;
    const bf16* zr = (const bf16*)(A.ws + WS_B) + row * DIN;
    bf16* MG = (bf16*)(A.ws + WS_A);
    float* out = A.out;
    const float un = bf2f(zr[C_U + cg_]);
    const float* sc = A.in[I_SC] + (size_t)bs * 3 * DM + cg_;
    const float s0 = sc[0], s1 = sc[DM], s2 = sc[2 * DM];
    const float* cw = A.in[I_CW] + cg_;
    const float uc = A.in[I_CB][cg_] + cw[0] * s0 + cw[DM] * s1 + cw[2 * DM] * s2 + cw[3 * DM] * un;
    out[O_CS + ((size_t)bs * 3 + 0) * DM + cg_] = s1; out[O_CS + ((size_t)bs * 3 + 1) * DM + cg_] = s2; out[O_CS + ((size_t)bs * 3 + 2) * DM + cg_] = un;
    float ra = A.in[I_BA][cg_], rx = A.in[I_BX][cg_];
    const float* wa = A.in[I_WA] + (size_t)n * 4096 + lane; const float* wx = A.in[I_WX] + (size_t)n * 4096 + lane;
#pragma unroll 32
    for (int c = 0; c < 64; ++c) { const float ucc = __shfl(uc, c); ra += ucc * wa[c * 64]; rx += ucc * wx[c * 64]; }
    const float r = sigmoidf_(ra), ig = sigmoidf_(rx);
    const float sp = log1pf(expf(-A.in[I_LAM][cg_]));
    const float la = -8.0f * r * sp, a = __expf(la);
    const float mult = sqrtf(fmaxf(1.0f - __expf(2.0f * la), 0.f));
    const float h = a * A.in[I_SL][(size_t)bs * DM + cg_] + mult * ig * uc;
    out[O_LS + (size_t)bs * DM + cg_] = h;
    const float rnn = gelu_tanh(bf2f(zr[C_G + cg_])) * h;
    const float qv = bf2f(zr[C_Q + cg_]);
    const float knew = bf2f(zr[C_K + 64 * kvh + lane]), vnew = bf2f(zr[C_V + 64 * kvh + lane]);
    scr[lane] = qv;
    LDS_FENCE();
    const float* ck = A.in[I_CK] + ((size_t)(bs * 128 + lane) * 4 + kvh) * 64;
    float d0 = 0.f, d1 = 0.f;
#pragma unroll
    for (int dd = 0; dd < 16; ++dd) { const f32x4 q4 = *(LAS f32x4*)(scr + 4 * dd); const f32x4 ka = ((const f32x4*)ck)[dd], kb = ((const f32x4*)(ck + 64 * 256))[dd];
        d0 += (q4.x * ka.x + q4.y * ka.y) + (q4.z * ka.z + q4.w * ka.w); d1 += (q4.x * kb.x + q4.y * kb.y) + (q4.z * kb.z + q4.w * kb.w); }
    const float d2 = wave_sum(qv * knew);
    const float sink = A.in[I_SINK][n];
    const float sa = d0 * 0.125f, sb = d1 * 0.125f, sn = d2 * 0.125f;
    float mx = wave_max(fmaxf(sa, sb)); mx = fmaxf(mx, fmaxf(sn, sink));
    const float p0 = __expf(sa - mx), p1 = __expf(sb - mx), p2 = __expf(sn - mx);
    const float den = wave_sum(p0 + p1) + p2 + __expf(sink - mx);
    scr[64 + lane] = p0; scr[128 + lane] = p1;
    LDS_FENCE();
    float o = p2 * vnew;
    const float* cv = A.in[I_CV] + ((size_t)(bs * 128) * 4 + kvh) * 64 + lane;
#pragma unroll 32
    for (int j = 0; j < 128; ++j) o += scr[64 + j] * cv[(size_t)j * 256];
    o = o / den;
    const float merged = sigmoidf_(bf2f(zr[C_GA + cg_])) * o + sigmoidf_(bf2f(zr[C_GR + cg_])) * rnn;
    MG[row * DM + cg_] = f2bf(merged);
    LDS_FENCE();
    if ((n & 3) == 0) { out[O_KWS + ((size_t)(bs * 128 + 127) * 4 + kvh) * 64 + lane] = knew; out[O_VWS + ((size_t)(bs * 128 + 127) * 4 + kvh) * 64 + lane] = vnew; }
}

template <class EpiS>
__device__ __forceinline__ void skinny_items(LAS unsigned char* lds, const bf16* Am, int lda, const bf16* Bt, int ldb, int n_tiles, int ksplit, int item_lo, int item_hi, int which, int G, const EpiS& epi) {
    const int tid = opaque_tid(), lane = tid & 63, wave = __builtin_amdgcn_readfirstlane(tid >> 6), lq = lane & 15, g = lane >> 4;
    if (which >= 0 && (int)(blockIdx.x & 1) != which) return;
    const int first = (which < 0) ? (int)blockIdx.x : (int)(blockIdx.x >> 1), step = (which < 0) ? G : (G >> 1);
    const int n_pairs = n_tiles >> 1;
    LAS f32x4* red = (LAS f32x4*)lds;
    for (int it = item_lo + first; it < item_hi; it += step) {
        const int np = it % n_pairs, kq = it / n_pairs;
        const int kb = kq * 1024 + wave * 128 + 8 * g;
        const bf16* ap = Am + (size_t)lq * lda + kb;
        const bf16* bp = Bt + (size_t)(32 * np + lq) * ldb + kb;
        f32x4 acc[8][2];
#pragma unroll
        for (int rt = 0; rt < 8; ++rt) { acc[rt][0] = (f32x4){0.f, 0.f, 0.f, 0.f}; acc[rt][1] = (f32x4){0.f, 0.f, 0.f, 0.f}; }
#pragma unroll 2
        for (int ks = 0; ks < 4; ++ks) {
            const bf16x8 b0 = *(const bf16x8*)(bp + 32 * ks), b1 = *(const bf16x8*)(bp + (size_t)16 * ldb + 32 * ks);
            bf16x8 a[8];
#pragma unroll
            for (int rt = 0; rt < 8; ++rt) a[rt] = *(const bf16x8*)(ap + (size_t)(16 * rt) * lda + 32 * ks);
#pragma unroll
            for (int rt = 0; rt < 8; ++rt) { acc[rt][0] = MFMA16(b0, a[rt], acc[rt][0]); acc[rt][1] = MFMA16(b1, a[rt], acc[rt][1]); } }
        RAW_BARRIER();
#pragma unroll
        for (int rt = 0; rt < 8; ++rt) { red[(wave * 16 + rt * 2 + 0) * 64 + lane] = acc[rt][0]; red[(wave * 16 + rt * 2 + 1) * 64 + lane] = acc[rt][1]; }
        RAW_BARRIER();
#pragma unroll
        for (int ct = 0; ct < 2; ++ct) { f32x4 sum = red[(wave * 2 + ct) * 64 + lane];
#pragma unroll
            for (int w2 = 1; w2 < 8; ++w2) sum += red[(w2 * 16 + wave * 2 + ct) * 64 + lane];
            epi(16 * wave + lq, 16 * (2 * np + ct) + 4 * g, kq, sum); }
    }
    RAW_BARRIER();
}

__device__ __forceinline__ void p3b_rows(const Args& A, int G, int wg_lo) {
    if ((int)blockIdx.x < wg_lo || (int)blockIdx.x >= wg_lo + 16) return;
    const int tid = opaque_tid(), lane = tid & 63, wave = __builtin_amdgcn_readfirstlane(tid >> 6);
    const int gw = ((int)blockIdx.x - wg_lo) * NWAVES + wave, NGW = 16 * NWAVES;
    const float* MIX = (const float*)(A.ws + WS_MIXS) - (size_t)MPR * DM; bf16* HN = (bf16*)(A.ws + WS_HN);
    const f32x4* g1 = (const f32x4*)A.in[I_GQM] + lane;
    for (int m = MPR + gw; m < MREAL; m += NGW) {
        unsigned long long* o8 = (unsigned long long*)(HN + (size_t)m * DM) + lane;
        const f32x4* mr = (const f32x4*)(MIX + (size_t)m * DM) + lane;
        const f32x4* xr = (const f32x4*)((m < MPR) ? A.in[I_XP] + (size_t)m * DM : A.in[I_XS] + (size_t)(m - MPR) * DM) + lane;
        f32x4* orow = (f32x4*)(A.out + (size_t)m * DM) + lane;
        f32x4 v[4], xv[4]; float s = 0.f;
#pragma unroll
        for (int j = 0; j < 4; ++j) { v[j] = mr[64 * j]; xv[j] = xr[64 * j]; s += (v[j].x * v[j].x + v[j].y * v[j].y) + (v[j].z * v[j].z + v[j].w * v[j].w); }
        const float rstd = 1.0f / sqrtf(wave_sum(s) * (1.f / DM) + EPS);
        float s2 = 0.f;
#pragma unroll
        for (int j = 0; j < 4; ++j) { xv[j] = xv[j] + v[j] * rstd * g1[64 * j]; orow[64 * j] = xv[j];
            s2 += (xv[j].x * xv[j].x + xv[j].y * xv[j].y) + (xv[j].z * xv[j].z + xv[j].w * xv[j].w); }
        const float rstd2 = 1.0f / sqrtf(wave_sum(s2) * (1.f / DM) + EPS);
        if (lane == 0) ((float*)(A.ws + WS_RS2))[m] = rstd2;
#pragma unroll
        for (int j = 0; j < 4; ++j) { const f32x4 o = xv[j];
            o8[64 * j] = (unsigned long long)pk2(o.x, o.y) | ((unsigned long long)pk2(o.z, o.w) << 32); }
    }
    asm volatile("s_waitcnt vmcnt(0)" ::: "memory"); RAW_BARRIER();
    if (tid == 0) { __builtin_amdgcn_fence(__ATOMIC_RELEASE, "agent"); __hip_atomic_fetch_add((unsigned*)(A.ws + WS_FLAG), 1u, __ATOMIC_RELAXED, __HIP_MEMORY_SCOPE_AGENT); }
}
__device__ __forceinline__ void wait_flag(unsigned* flag, unsigned want) {
    if (threadIdx.x == 0) { unsigned sp = 0; while (__hip_atomic_load(flag, __ATOMIC_RELAXED, __HIP_MEMORY_SCOPE_AGENT) < want) { __builtin_amdgcn_s_sleep(2); if (++sp > (1u << 22)) break; }
        __builtin_amdgcn_fence(__ATOMIC_ACQUIRE, "agent"); asm volatile("s_waitcnt vmcnt(0)" ::: "memory"); }
    RAW_BARRIER();
}
__device__ __forceinline__ void p5b_rows(const Args& A, int G) {
    if ((blockIdx.x & 1) || blockIdx.x >= 32) return;
    wait_flag((unsigned*)(A.ws + WS_FLAG) + 64, 128u);
    const int tid = opaque_tid(), lane = tid & 63, wave = __builtin_amdgcn_readfirstlane(tid >> 6);
    const int gw = (int)(blockIdx.x >> 1) * NWAVES + wave, NGW = 16 * NWAVES;
    const float* F = (const float*)(A.ws + WS_A);
    const f32x4* g1 = (const f32x4*)A.in[I_GQF] + lane;
    for (int m = MPR + gw; m < MREAL; m += NGW) {
        const f32x4* fr = (const f32x4*)(F + (size_t)m * DM) + lane;
        f32x4* orow = (f32x4*)(A.out + (size_t)m * DM) + lane;
        f32x4 v[4], xv[4]; float s = 0.f;
        if (m >= MPR) { const f32x4* pr = (const f32x4*)((const float*)(A.ws + WS_WOUT) + (size_t)(m - MPR) * DM) + lane;
#pragma unroll
            for (int j = 0; j < 4; ++j) v[j] = (pr[64 * j] + pr[64 * j + DBATCH * DM / 4]) + (pr[64 * j + 2 * (DBATCH * DM / 4)] + pr[64 * j + 3 * (DBATCH * DM / 4)]); }
        else {
#pragma unroll
            for (int j = 0; j < 4; ++j) v[j] = fr[64 * j]; }
#pragma unroll
        for (int j = 0; j < 4; ++j) { xv[j] = orow[64 * j]; s += (v[j].x * v[j].x + v[j].y * v[j].y) + (v[j].z * v[j].z + v[j].w * v[j].w); }
        const float rstd = 1.0f / sqrtf(wave_sum(s) * (1.f / DM) + EPS);
#pragma unroll
        for (int j = 0; j < 4; ++j) orow[64 * j] = xv[j] + v[j] * rstd * g1[64 * j];
    }
}

__global__ void __launch_bounds__(NWAVES * 64, 2) mega_fwd(Args args) {
    extern __shared__ __attribute__((aligned(16))) unsigned char lds_raw[];
    cg::grid_group grid = cg::this_grid();
    LAS unsigned char* lds = (LAS unsigned char*)lds_raw;
    const int G = gridDim.x;
    unsigned char* ws = args.ws;
    if (threadIdx.x == 0) { ((volatile LAS unsigned*)(lds + L_MISC))[0] = 0u; ((volatile LAS unsigned*)(lds + L_MISC))[1] = 0u; }
    __syncthreads();
    const XcdBarrier bar = xcd_barrier_post((unsigned*)ws, (volatile LAS unsigned*)(lds + L_MISC));

    p0_prologue(args, lds, G);
    if (G == 0x7fffffff) grid.sync();
    xcd_barrier(bar);
    { pg8::Gemm g{(const bf16*)(ws + WS_XS), (const bf16*)(ws + WS_WIN), MPAD, DIN, DM}; pg8::StaticOrder S; S.init(MPR, DIN, G, (int)blockIdx.x);
      pg8::EpiBf16<0> E{(bf16*)(ws + WS_B), DIN, nullptr};
      pg8::gemm_phase<pg8::EpiBf16<0>, pg8::StaticOrder, true, true>(lds, g, S, E);
      bf16* Zs = (bf16*)(ws + WS_B) + (size_t)MPR * DIN;
      skinny_items(lds, (const bf16*)(ws + WS_XS) + (size_t)MPR * DM, DM, (const bf16*)(ws + WS_WIN), DM, DIN / 16, 1, 0, DIN / 32, -1, G,
                   [Zs](int r, int c, int, const f32x4& a) { *(v2u*)(Zs + (size_t)r * DIN + c) = (v2u){pk2(a[0], a[1]), pk2(a[2], a[3])}; }); }
    xcd_barrier(bar);
    for (int u0 = blockIdx.x; u0 < NBATCH * NHEAD; u0 += G) { const int u = (G == 256) ? (((u0 & 7) * 2 + ((u0 >> 3) >> 4)) << 4) + ((u0 >> 3) & 15) : u0;
        p2_prompt_unit(args, lds, u >> 4, u & 15); }
    { const int tid = opaque_tid(), lane = tid & 63, wave = __builtin_amdgcn_readfirstlane(tid >> 6);
      for (int it = blockIdx.x * NWAVES + wave; it < DBATCH * NHEAD; it += G * NWAVES) p2_sample_item(args, (LAS float*)(lds + L_SMP + wave * 1024), it >> 4, it & 15, lane); }
    xcd_barrier(bar);
    { pg8::Gemm g{(const bf16*)(ws + WS_A), (const bf16*)(ws + WS_WOUT), MPR, DM, DM}; pg8::StaticOrder S; S.init(MPR, DM, G, (int)blockIdx.x);
      pg8::PanelRms st1{(float*)(ws + WS_MIXS + 1 * MiB), (unsigned*)(ws + WS_CNT)}; pg8::PanelPublish st2{(float*)(ws + WS_MIXS + 2 * MiB), (unsigned*)(ws + WS_CNT + CNT_BANK), (float*)(ws + WS_RS2)};
      pg8::EpiRmsResRms E{(const bf16*)(ws + WS_XS), (const float*)(ws + WS_RS), (bf16*)(ws + WS_X1), args.in[I_GQM], st1, st2};
      float* Ms = (float*)(ws + WS_MIXS);
      auto epis = [Ms](int r, int c, int, const f32x4& a) { *(f32x4*)(Ms + (size_t)r * DM + c) = a; };
      skinny_items(lds, (const bf16*)(ws + WS_A) + (size_t)MPR * DM, DM, (const bf16*)(ws + WS_WOUT), DM, DM / 16, 1, 0, DM / 32, 1, G, epis);
      for (int i = 0; i < 2; ++i) { pg8::OneUnit U; U.valid = S.next(i, U.u);
          pg8::gemm_phase<pg8::EpiRmsResRms, pg8::OneUnit, false, true>(lds, g, U, E);
          RAW_BARRIER(); }
    }
    xcd_barrier(bar);
    p3b_rows(args, G, 128);
    { pg8::Gemm g{(const bf16*)(ws + WS_X1), (const bf16*)(ws + WS_WUP), MPAD, DFF, DM}; pg8::StaticOrder S; S.init(MPR, DFF, G, (int)blockIdx.x);
      pg8::EpiBf16<3> E{(bf16*)(ws + WS_H), DFF, (const float*)(ws + WS_RS2)};
      pg8::gemm_phase<pg8::EpiBf16<3>, pg8::StaticOrder, true, true>(lds, g, S, E);
      if (blockIdx.x < DFF / 32) wait_flag((unsigned*)(ws + WS_FLAG), 16u);
      bf16* Hs = (bf16*)(ws + WS_H) + (size_t)MPR * DFF;
      skinny_items(lds, (const bf16*)(ws + WS_HN) + (size_t)MPR * DM, DM, (const bf16*)(ws + WS_WUP), DM, DFF / 16, 1, 0, DFF / 32, -1, G,
                   [Hs, rs2s = (const float*)(ws + WS_RS2) + MPR](int r, int c, int, const f32x4& a) { const float q = rs2s[r], q2 = q * q;
                       const float x0 = fmaxf(a[0], 0.f), x1 = fmaxf(a[1], 0.f), x2 = fmaxf(a[2], 0.f), x3 = fmaxf(a[3], 0.f);
                       *(v2u*)(Hs + (size_t)r * DFF + c) = (v2u){pk2(x0 * x0 * q2, x1 * x1 * q2), pk2(x2 * x2 * q2, x3 * x3 * q2)}; }); }
    xcd_barrier(bar);
    { pg8::Gemm g{(const bf16*)(ws + WS_H), (const bf16*)(ws + WS_WDN), MPR, DM, DFF}; pg8::StaticOrder S; S.init(MPR, DM, G, (int)blockIdx.x);
      pg8::PanelRms st{(float*)(ws + WS_MIXS + 1 * MiB), (unsigned*)(ws + WS_CNT + 2 * CNT_BANK)};
      pg8::EpiRmsRes E{(const bf16*)(ws + WS_X1), args.out, args.in[I_GQF], st};
      float* Fp = (float*)(ws + WS_WOUT);
      auto epis = [Fp](int r, int c, int kq, const f32x4& a) { *(f32x4*)(Fp + ((size_t)kq * DBATCH + r) * DM + c) = a; };
      skinny_items(lds, (const bf16*)(ws + WS_H) + (size_t)MPR * DFF, DFF, (const bf16*)(ws + WS_WDN), DFF, DM / 16, 4, 0, 4 * (DM / 32), 1, G, epis);
      if (blockIdx.x & 1) { asm volatile("s_waitcnt vmcnt(0)" ::: "memory"); RAW_BARRIER();
          if (threadIdx.x == 0) { __builtin_amdgcn_fence(__ATOMIC_RELEASE, "agent"); __hip_atomic_fetch_add((unsigned*)(ws + WS_FLAG) + 64, 1u, __ATOMIC_RELAXED, __HIP_MEMORY_SCOPE_AGENT); } }
      for (int i = 1; i >= 0; --i) { pg8::OneUnit U; U.valid = S.next(i, U.u);
          pg8::gemm_phase<pg8::EpiRmsRes, pg8::OneUnit, false, true>(lds, g, U, E);
          RAW_BARRIER(); }
    }
    p5b_rows(args, G);
}

extern "C" void kernel_launch(void* const* d_in, const int* in_sizes, int n_in, void* d_out, int out_size, void* d_ws, size_t ws_size, hipStream_t stream) {
    static int grid = 0;
    if (grid == 0) {
        if (n_in != 22 || ws_size < WS_NEED) { fprintf(stderr, "kernel_launch: unexpected n_in %d or ws_size %zu (< %zu)\n", n_in, ws_size, (size_t)WS_NEED); grid = -1; return; }
        int dev = 0, cus = 0, per_cu = 0;
        (void)hipGetDevice(&dev);
        (void)hipDeviceGetAttribute(&cus, hipDeviceAttributeMultiprocessorCount, dev);
        (void)hipFuncSetAttribute((const void*)mega_fwd, hipFuncAttributeMaxDynamicSharedMemorySize, LDS_BYTES);
        (void)hipOccupancyMaxActiveBlocksPerMultiprocessor(&per_cu, (const void*)mega_fwd, NWAVES * 64, LDS_BYTES);
        if (per_cu < 1) { fprintf(stderr, "kernel_launch: occupancy query gave %d\n", per_cu); per_cu = 1; }
        (void)hipGetLastError();
        grid = cus * per_cu;
    }
    if (grid < 0) return;
    Args a{};
    for (int i = 0; i < 22; ++i) a.in[i] = (const float*)d_in[i];
    a.out = (float*)d_out; a.ws = (unsigned char*)d_ws;
    if (hipMemsetAsync(d_ws, 0, CTL_BYTES, stream) != hipSuccess) { fprintf(stderr, "kernel_launch: memset failed\n"); return; }
    void* kargs[] = {&a};
    hipError_t e = hipLaunchCooperativeKernel((const void*)mega_fwd, dim3(grid), dim3(NWAVES * 64), kargs, LDS_BYTES, stream);
    if (e != hipSuccess) fprintf(stderr, "cooperative launch failed: %s (grid %d)\n", hipGetErrorString(e), grid);
}
```

```cpp
#include <hip/hip_runtime.h>
#include <hip/hip_cooperative_groups.h>
#include <cstdio>
#include <cstdint>
namespace cg = cooperative_groups;

#define LAS __attribute__((address_space(3)))
typedef unsigned short bf16;
typedef unsigned v4u __attribute__((ext_vector_type(4)));
typedef unsigned v2u __attribute__((ext_vector_type(2)));
typedef float f32x4 __attribute__((ext_vector_type(4)));
typedef float f32x2 __attribute__((ext_vector_type(2)));
typedef short bf16x8 __attribute__((ext_vector_type(8)));
typedef short s16x4 __attribute__((ext_vector_type(4)));
typedef __bf16 b16x2 __attribute__((ext_vector_type(2)));

__device__ __forceinline__ unsigned pk2(float lo, float hi) { f32x2 v = {lo, hi}; b16x2 r = __builtin_convertvector(v, b16x2); return __builtin_bit_cast(unsigned, r); }
__device__ __forceinline__ bf16 f2bf(float f) { return (bf16)(pk2(f, 0.f) & 0xffffu); }
__device__ __forceinline__ float bf2f(bf16 h) { return __uint_as_float((unsigned)h << 16); }
__device__ __forceinline__ float bflo(unsigned w) { return __uint_as_float(w << 16); }
__device__ __forceinline__ float bfhi(unsigned w) { return __uint_as_float(w & 0xffff0000u); }
__device__ __forceinline__ float sigmoidf_(float x) { return __builtin_amdgcn_rcpf(1.0f + __expf(-x)); }
__device__ __forceinline__ float gelu_tanh(float x) { const float y = 0.7978845608028654f * (x + 0.044715f * x * x * x); return x * sigmoidf_(2.0f * y); }
__device__ __forceinline__ int opaque_tid() { int t = threadIdx.x; asm volatile("" : "+v"(t)); return t; }
__device__ __forceinline__ float wave_sum(float v) {
#pragma unroll
    for (int o = 1; o < 64; o <<= 1) v += __shfl_xor(v, o);
    return v;
}
__device__ __forceinline__ float wave_max(float v) {
#pragma unroll
    for (int o = 1; o < 64; o <<= 1) v = fmaxf(v, __shfl_xor(v, o));
    return v;
}

namespace pg8 {
#define PG8_LAS __attribute__((address_space(3)))
typedef unsigned short bf16_t;
typedef short bf16x8 __attribute__((ext_vector_type(8)));
typedef float f32x4 __attribute__((ext_vector_type(4)));
typedef unsigned u32x4 __attribute__((ext_vector_type(4)));
constexpr int BM = 256, BK = 64, HALF = 128, HTB = HALF * BK * 2, STAGE_BYTES = 8 * HTB, NXCD = 8, WGM = 8;

__host__ __device__ __forceinline__ int lds_byte(int r, int c) { const int st = (r >> 4) * 2 + (c >> 5), rr = r & 15, cc = c & 31, ob = rr * 64 + cc * 2; return st * 1024 + (ob ^ (((ob >> 9) & 1) << 5)); }
__host__ __device__ __forceinline__ void stage_rc(int b, int& R, int& C) { const int st = b / 1024, sb = b % 1024, swz = sb ^ (((sb >> 9) & 1) << 5); R = (st >> 1) * 16 + swz / 64; C = (st & 1) * 32 + (swz % 64) / 2; }
__host__ __device__ __forceinline__ int perm32(int rho) { const int n = rho >> 4, i = rho & 15; return 8 * (i >> 2) + 4 * n + (i & 3); }

struct Unit { int pm, pn; };
struct Gemm { const bf16_t* A; const bf16_t* Bt; int M, N, K; };

struct StaticOrder {
    int nM, nN, nwg, G, c;
    __host__ __device__ void init(int M, int N, int G_, int c_) { nM = M / BM; nN = N / BM; nwg = nM * nN; G = G_; c = c_; }
    __host__ __device__ bool next(int i, Unit& u) const {
        const long L = (long)i * G + c; if (L >= nwg) return false;
        int wgid = (int)L; { const int q = nwg / NXCD, r = nwg % NXCD, xcd = wgid % NXCD, off = wgid / NXCD; wgid = (xcd < r ? xcd * (q + 1) : r * (q + 1) + (xcd - r) * q) + off; }
        const int nig = WGM * nN, gid = wgid / nig, fm = gid * WGM, gsz = (nM - fm) < WGM ? (nM - fm) : WGM;
        u.pm = fm + ((wgid % nig) % gsz); u.pn = (wgid % nig) / gsz; return true;
    }
    __device__ __forceinline__ void a_ready(const Unit&) const {}
    __device__ __forceinline__ void done(const Unit&) const {}
};

template <int ACT  > struct EpiBf16 {
    static constexpr bool PERM = true, AFTER_DRAIN = false, ROWSCALE = (ACT == 3);
    bf16_t* O; int ldc; const float* rowscale;
    __device__ __forceinline__ void operator()(const f32x4 (&acc)[2][2][4][2], const Unit& u, int wr, int wc, int fr, int fq, const float (&rsc)[2][4]) const {
        const int row0 = u.pm * BM + wr * 64 + fr; const int col0 = u.pn * BM + wc * 32 + 8 * fq;
#pragma unroll
        for (int ai = 0; ai < 2; ++ai)
#pragma unroll
            for (int m = 0; m < 4; ++m) { bf16_t* rowp = O + (size_t)(row0 + ai * HALF + m * 16) * ldc + col0;
                const float q2 = (ACT == 3) ? rsc[ai][m] * rsc[ai][m] : 1.0f;
#pragma unroll
                for (int bj = 0; bj < 2; ++bj) { f32x4 v0 = acc[ai][bj][m][0], v1 = acc[ai][bj][m][1];
                    if (ACT >= 2) {
#pragma unroll
                        for (int e = 0; e < 4; ++e) { const float a = fmaxf(v0[e], 0.f), b = fmaxf(v1[e], 0.f); v0[e] = a * a * q2; v1[e] = b * b * q2; } }
                    u32x4 w; w.x = pk2(v0[0], v0[1]); w.y = pk2(v0[2], v0[3]); w.z = pk2(v1[0], v1[1]); w.w = pk2(v1[2], v1[3]);
                    *(u32x4*)(rowp + bj * HALF) = w; } }
    }
};
struct EpiF32 {
    static constexpr bool PERM = false, AFTER_DRAIN = false, ROWSCALE = false;
    float* O; int ldc;
    __device__ __forceinline__ void operator()(const f32x4 (&acc)[2][2][4][2], const Unit& u, int wr, int wc, int fr, int fq, const float (&rsc)[2][4]) const {
        const int row0 = u.pm * BM + wr * 64 + fr; const int col0 = u.pn * BM + wc * 32 + 4 * fq;
#pragma unroll
        for (int ai = 0; ai < 2; ++ai)
#pragma unroll
            for (int m = 0; m < 4; ++m) { float* rowp = O + (size_t)(row0 + ai * HALF + m * 16) * ldc + col0;
#pragma unroll
                for (int bj = 0; bj < 2; ++bj)
#pragma unroll
                    for (int n = 0; n < 2; ++n) *(f32x4*)(rowp + bj * HALF + n * 16) = acc[ai][bj][m][n]; }
    }
};


struct OneUnit { Unit u; bool valid;
    __device__ __forceinline__ bool next(int i, Unit& o) const { if (i == 0 && valid) { o = u; return true; } return false; }
    __device__ __forceinline__ void a_ready(const Unit&) const {}
    __device__ __forceinline__ void done(const Unit&) const {} };
struct PanelRms {
    float* xbuf;
    unsigned* cnt;
    __device__ __forceinline__ void run(const f32x4 (&v)[2][2][4][2], const Unit& u, int wr, int wc, int fr, int fq, PG8_LAS unsigned char* lds, int wid, int lane) const {
        PG8_LAS float* P = (PG8_LAS float*)lds;
        PG8_LAS float* S = (PG8_LAS float*)(lds + 4096);
#pragma unroll
        for (int ai = 0; ai < 2; ++ai)
#pragma unroll
            for (int m = 0; m < 4; ++m) { float s = 0.f;
#pragma unroll
                for (int bj = 0; bj < 2; ++bj)
#pragma unroll
                    for (int n = 0; n < 2; ++n) { const f32x4 x = v[ai][bj][m][n]; s += (x[0] * x[0] + x[1] * x[1]) + (x[2] * x[2] + x[3] * x[3]); }
                s += __shfl_xor(s, 16); s += __shfl_xor(s, 32);
                if (fq == 0) P[(ai * HALF + wr * 64 + m * 16 + fr) * 4 + wc] = s; }
        asm volatile("s_waitcnt lgkmcnt(0)" ::: "memory"); __builtin_amdgcn_s_barrier(); asm volatile("" ::: "memory");
        const int row = wid * 32 + (lane & 31);
        if (lane < 32) { const f32x4 p = *(const PG8_LAS f32x4*)(P + row * 4);
            __hip_atomic_store(xbuf + ((size_t)(u.pm * BM + row) * 4 + u.pn), (p[0] + p[1]) + (p[2] + p[3]), __ATOMIC_RELAXED, __HIP_MEMORY_SCOPE_AGENT); }
        asm volatile("s_waitcnt vmcnt(0)" ::: "memory");
        if (lane == 0) __hip_atomic_fetch_add(cnt + 64 * u.pm, 1u, __ATOMIC_RELAXED, __HIP_MEMORY_SCOPE_AGENT);
        if (wid == 0) { unsigned sp = 0;
            while ((unsigned)__builtin_amdgcn_readfirstlane(__hip_atomic_load(cnt + 64 * u.pm, __ATOMIC_RELAXED, __HIP_MEMORY_SCOPE_AGENT)) < 32u) { __builtin_amdgcn_s_sleep(2); if (++sp > (1u << 22)) break; }
            __builtin_amdgcn_fence(__ATOMIC_ACQUIRE, "agent"); }
        asm volatile("s_waitcnt vmcnt(0) lgkmcnt(0)" ::: "memory"); __builtin_amdgcn_s_barrier(); asm volatile("" ::: "memory");
        if (lane < 32) { const float* slot = xbuf + (size_t)(u.pm * BM + row) * 4; float t = 0.f;
#pragma unroll
            for (int k = 0; k < 4; ++k) t += __hip_atomic_load(slot + k, __ATOMIC_RELAXED, __HIP_MEMORY_SCOPE_AGENT);
            S[row] = 1.0f / sqrtf(t * (1.0f / 1024.0f) + 1e-6f); }
        asm volatile("s_waitcnt lgkmcnt(0)" ::: "memory"); __builtin_amdgcn_s_barrier(); asm volatile("" ::: "memory");
    }
};
struct PanelPublish {
    float* xbuf; unsigned* cnt; float* rs2;
    __device__ __forceinline__ void run(const f32x4 (&v)[2][2][4][2], const Unit& u, int wr, int wc, int fr, int fq, PG8_LAS unsigned char* lds, int wid, int lane) const {
        PG8_LAS float* P = (PG8_LAS float*)(lds + 8192);
#pragma unroll
        for (int ai = 0; ai < 2; ++ai)
#pragma unroll
            for (int m = 0; m < 4; ++m) { float s = 0.f;
#pragma unroll
                for (int bj = 0; bj < 2; ++bj)
#pragma unroll
                    for (int n = 0; n < 2; ++n) { const f32x4 x = v[ai][bj][m][n]; s += (x[0] * x[0] + x[1] * x[1]) + (x[2] * x[2] + x[3] * x[3]); }
                s += __shfl_xor(s, 16); s += __shfl_xor(s, 32);
                if (fq == 0) P[(ai * HALF + wr * 64 + m * 16 + fr) * 4 + wc] = s; }
        asm volatile("s_waitcnt lgkmcnt(0)" ::: "memory"); __builtin_amdgcn_s_barrier(); asm volatile("" ::: "memory");
        const int row = wid * 32 + (lane & 31);
        if (lane < 32) { const f32x4 p = *(const PG8_LAS f32x4*)(P + row * 4);
            __hip_atomic_store(xbuf + ((size_t)(u.pm * BM + row) * 4 + u.pn), (p[0] + p[1]) + (p[2] + p[3]), __ATOMIC_RELAXED, __HIP_MEMORY_SCOPE_AGENT); }
        asm volatile("s_waitcnt vmcnt(0)" ::: "memory");
        unsigned old = 0u; if (lane == 0) old = __hip_atomic_fetch_add(cnt + 64 * u.pm, 1u, __ATOMIC_RELAXED, __HIP_MEMORY_SCOPE_AGENT);
        old = (unsigned)__builtin_amdgcn_readfirstlane(old);
        if (old == 31u) {
            __builtin_amdgcn_fence(__ATOMIC_ACQUIRE, "agent");
#pragma unroll
            for (int rr = 0; rr < 4; ++rr) { const int r = lane + 64 * rr; const float* slot = xbuf + (size_t)(u.pm * BM + r) * 4; float t = 0.f;
#pragma unroll
                for (int k = 0; k < 4; ++k) t += __hip_atomic_load(slot + k, __ATOMIC_RELAXED, __HIP_MEMORY_SCOPE_AGENT);
                rs2[u.pm * BM + r] = 1.0f / sqrtf(t * (1.0f / 1024.0f) + 1e-6f); } }
    }
};
struct EpiRmsResRms {
    static constexpr bool PERM = true, AFTER_DRAIN = true, ROWSCALE = false;
    const bf16_t* xs; const float* rsx; bf16_t* x1b; const float* g1; PanelRms st1; PanelPublish st2;
    __device__ __forceinline__ void fused(f32x4 (&acc)[2][2][4][2], const Unit& u, int wr, int wc, int fr, int fq, PG8_LAS unsigned char* lds, int wid, int lane) const {
        const PG8_LAS float* S = (const PG8_LAS float*)(lds + 4096);
        const int col0 = u.pn * BM + wc * 32 + 8 * fq;
        u32x4 pre[2][4][2]; float irs[2][4];
#pragma unroll
        for (int ai = 0; ai < 2; ++ai)
#pragma unroll
            for (int m = 0; m < 4; ++m) { const int grow = u.pm * BM + ai * HALF + wr * 64 + m * 16 + fr; const size_t off = (size_t)grow * 1024 + col0;
                irs[ai][m] = rsx[grow];
#pragma unroll
                for (int bj = 0; bj < 2; ++bj) pre[ai][m][bj] = *(const u32x4*)(xs + off + bj * HALF); }
        st1.run(acc, u, wr, wc, fr, fq, lds, wid, lane);
        f32x4 gv[2][2];
#pragma unroll
        for (int bj = 0; bj < 2; ++bj)
#pragma unroll
            for (int n = 0; n < 2; ++n) gv[bj][n] = *(const f32x4*)(g1 + col0 + bj * HALF + n * 4);
#pragma unroll
        for (int ai = 0; ai < 2; ++ai)
#pragma unroll
            for (int m = 0; m < 4; ++m) { const int r = ai * HALF + wr * 64 + m * 16 + fr; const float rs = S[r]; const float ix = 1.0f / irs[ai][m];
#pragma unroll
                for (int bj = 0; bj < 2; ++bj) { const u32x4 p = pre[ai][m][bj];
                    const f32x4 b0 = (f32x4){__uint_as_float(p.x << 16), __uint_as_float(p.x & 0xffff0000u), __uint_as_float(p.y << 16), __uint_as_float(p.y & 0xffff0000u)};
                    const f32x4 b1 = (f32x4){__uint_as_float(p.z << 16), __uint_as_float(p.z & 0xffff0000u), __uint_as_float(p.w << 16), __uint_as_float(p.w & 0xffff0000u)};
                    const f32x4 a0 = b0 * ix + acc[ai][bj][m][0] * rs * gv[bj][0], a1 = b1 * ix + acc[ai][bj][m][1] * rs * gv[bj][1];
                    acc[ai][bj][m][0] = a0; acc[ai][bj][m][1] = a1;
                    u32x4 w; w.x = pk2(a0[0], a0[1]); w.y = pk2(a0[2], a0[3]); w.z = pk2(a1[0], a1[1]); w.w = pk2(a1[2], a1[3]);
                    *(u32x4*)(x1b + (size_t)(u.pm * BM + r) * 1024 + col0 + bj * HALF) = w; }
                asm volatile("" : "+v"(acc[ai][0][m][0]), "+v"(acc[ai][0][m][1]), "+v"(acc[ai][1][m][0]), "+v"(acc[ai][1][m][1])); }
        asm volatile("" ::: "memory");
        st2.run(acc, u, wr, wc, fr, fq, lds, wid, lane);
    }
};
struct EpiRmsRes {
    static constexpr bool PERM = true, AFTER_DRAIN = true, ROWSCALE = false;
    const bf16_t* x1b; float* out; const float* g1; PanelRms st;
    __device__ __forceinline__ void fused(f32x4 (&acc)[2][2][4][2], const Unit& u, int wr, int wc, int fr, int fq, PG8_LAS unsigned char* lds, int wid, int lane) const {
        const PG8_LAS float* S = (const PG8_LAS float*)(lds + 4096);
        const int col0 = u.pn * BM + wc * 32 + 8 * fq;
        u32x4 pre[2][4][2];
#pragma unroll
        for (int ai = 0; ai < 2; ++ai)
#pragma unroll
            for (int m = 0; m < 4; ++m) { const size_t off = (size_t)(u.pm * BM + ai * HALF + wr * 64 + m * 16 + fr) * 1024 + col0;
#pragma unroll
                for (int bj = 0; bj < 2; ++bj) pre[ai][m][bj] = *(const u32x4*)(x1b + off + bj * HALF); }
        st.run(acc, u, wr, wc, fr, fq, lds, wid, lane);
        f32x4 gv[2][2];
#pragma unroll
        for (int bj = 0; bj < 2; ++bj)
#pragma unroll
            for (int n = 0; n < 2; ++n) gv[bj][n] = *(const f32x4*)(g1 + col0 + bj * HALF + n * 4);
#pragma unroll
        for (int ai = 0; ai < 2; ++ai)
#pragma unroll
            for (int m = 0; m < 4; ++m) { const int r = ai * HALF + wr * 64 + m * 16 + fr; const float rs = S[r]; const size_t off = (size_t)(u.pm * BM + r) * 1024 + col0;
#pragma unroll
                for (int bj = 0; bj < 2; ++bj) { const u32x4 p = pre[ai][m][bj];
                    const f32x4 b0 = (f32x4){__uint_as_float(p.x << 16), __uint_as_float(p.x & 0xffff0000u), __uint_as_float(p.y << 16), __uint_as_float(p.y & 0xffff0000u)};
                    const f32x4 b1 = (f32x4){__uint_as_float(p.z << 16), __uint_as_float(p.z & 0xffff0000u), __uint_as_float(p.w << 16), __uint_as_float(p.w & 0xffff0000u)};
                    *(f32x4*)(out + off + bj * HALF) = b0 + acc[ai][bj][m][0] * rs * gv[bj][0];
                    *(f32x4*)(out + off + bj * HALF + 4) = b1 + acc[ai][bj][m][1] * rs * gv[bj][1]; } }
    }
};

template <class Epi, class Sched, bool ALIGN_EPI = false, bool SP2 = false>
__device__ __forceinline__ void gemm_phase(PG8_LAS unsigned char* lds, const Gemm g, const Sched& S, const Epi& E) {
    const int tid = opaque_tid(), wid = __builtin_amdgcn_readfirstlane(tid >> 6), lane = tid & 63, wr = wid >> 2, wc = wid & 3, fr = lane & 15, fq = lane >> 4;
    const int K = g.K, nt = K / BK;
    unsigned voffA[2], voffB[2];
#pragma unroll
    for (int i = 0; i < 2; ++i) { int R, C; stage_rc(tid * 16 + i * 8192, R, C); const int Rb = Epi::PERM ? ((R & ~31) + perm32(R & 31)) : R;
        voffA[i] = (unsigned)(R * K + C) * 2u; voffB[i] = (unsigned)(Rb * K + C) * 2u; }
    const size_t kstep = (size_t)(BK * 2);
    const size_t hstep = (size_t)HALF * K * 2;
    const size_t tstep = 2 * hstep;
    const unsigned ldsw = (unsigned)wid * 1024u;
    const int aoff = lds_byte(wr * 64 + fr, fq * 8), boff = lds_byte(wc * 32 + fr, fq * 8);
#define PG8_SA(b, h) (((b) * 2 + (h)) * HTB)
#define PG8_SB(b, h) ((4 + (b) * 2 + (h)) * HTB)
#define PG8_STAGE(bufoff, gbase, voff) do { _Pragma("unroll") for (int _i = 0; _i < 2; ++_i) \
        __builtin_amdgcn_global_load_lds((const unsigned*)((const char*)(gbase) + (voff)[_i]), (PG8_LAS unsigned*)(lds + (bufoff) + ldsw + _i * 8192), 16, 0, 0); } while (0)
#define PG8_LDA(dst, b, h) do { _Pragma("unroll") for (int m = 0; m < 4; ++m) _Pragma("unroll") for (int k = 0; k < 2; ++k) dst[m][k] = *(const PG8_LAS bf16x8*)(lds + PG8_SA(b, h) + aoff + m * 2048 + k * 1024); } while (0)
#define PG8_LDB(dst, b, h) do { _Pragma("unroll") for (int n = 0; n < 2; ++n) _Pragma("unroll") for (int k = 0; k < 2; ++k) dst[n][k] = *(const PG8_LAS bf16x8*)(lds + PG8_SB(b, h) + boff + n * 2048 + k * 1024); } while (0)
#define PG8_MMA(ai, bj, At, Bt) do { __builtin_amdgcn_s_setprio(1); _Pragma("unroll") for (int m = 0; m < 4; ++m) _Pragma("unroll") for (int n = 0; n < 2; ++n) _Pragma("unroll") for (int k = 0; k < 2; ++k) \
        acc[ai][bj][m][n] = __builtin_amdgcn_mfma_f32_16x16x32_bf16(Bt[n][k], At[m][k], acc[ai][bj][m][n], 0, 0, 0); __builtin_amdgcn_s_setprio(0); } while (0)
#define PG8_WAIT_V(n) asm volatile("s_waitcnt vmcnt(" #n ")" ::: "memory")
#define PG8_WAIT_L(n) asm volatile("s_waitcnt lgkmcnt(" #n ")" ::: "memory")
#define PG8_BAR __builtin_amdgcn_s_barrier()
#define PG8_SCHED __builtin_amdgcn_sched_barrier(0)
    Unit cur, nxt; int ui = 0;
    if (!S.next(0, cur)) return;
    f32x4 acc[2][2][4][2];
#pragma unroll
    for (int a = 0; a < 2; ++a)
#pragma unroll
        for (int b = 0; b < 2; ++b)
#pragma unroll
            for (int m = 0; m < 4; ++m)
#pragma unroll
                for (int n = 0; n < 2; ++n) acc[a][b][m][n] = (f32x4){0.f, 0.f, 0.f, 0.f};
    bf16x8 At[4][2], B0[2][2], B1[2][2];
    float rsc[2][4] = {{1.f, 1.f, 1.f, 1.f}, {1.f, 1.f, 1.f, 1.f}};
    const char* cA = (const char*)g.A + (size_t)cur.pm * tstep; const char* cB = (const char*)g.Bt + (size_t)cur.pn * tstep;
    S.a_ready(cur);
    if constexpr (SP2) {
        PG8_STAGE(PG8_SB(0, 0), cB, voffB); PG8_STAGE(PG8_SB(0, 1), cB + hstep, voffB); PG8_STAGE(PG8_SA(0, 0), cA, voffA); PG8_STAGE(PG8_SA(0, 1), cA + hstep, voffA);
        if (wr == 1) PG8_BAR;
        PG8_WAIT_V(2); PG8_BAR;
        PG8_STAGE(PG8_SB(1, 0), cB + kstep, voffB); PG8_STAGE(PG8_SA(1, 0), cA + kstep, voffA); PG8_STAGE(PG8_SB(1, 1), cB + hstep + kstep, voffB);
        PG8_WAIT_V(6); PG8_BAR;
    } else {
        PG8_STAGE(PG8_SB(0, 0), cB, voffB); PG8_STAGE(PG8_SA(0, 0), cA, voffA); PG8_STAGE(PG8_SB(0, 1), cB + hstep, voffB); PG8_STAGE(PG8_SA(0, 1), cA + hstep, voffA);
        if (wr == 1) PG8_BAR;
        PG8_WAIT_V(4); PG8_BAR;
        PG8_STAGE(PG8_SB(1, 0), cB + kstep, voffB); PG8_STAGE(PG8_SA(1, 0), cA + kstep, voffA); PG8_STAGE(PG8_SB(1, 1), cB + hstep + kstep, voffB);
        PG8_WAIT_V(6); PG8_BAR;
    }
    for (;;) {
        const bool has_next = S.next(ui + 1, nxt);
        const char* nA = has_next ? (const char*)g.A + (size_t)nxt.pm * tstep : cA; const char* nB = has_next ? (const char*)g.Bt + (size_t)nxt.pn * tstep : cB;
        for (int t = 0; t < nt; t += 2) {
            const bool last = (t == nt - 2);
            const char* a1 = cA + (size_t)(t + 1) * kstep;
            const char* a2 = last ? nA : cA + (size_t)(t + 2) * kstep; const char* b2 = last ? nB : cB + (size_t)(t + 2) * kstep;
            const char* a3 = a2 + kstep; const char* b3 = b2 + kstep;
            if (last && has_next) S.a_ready(nxt);
            if constexpr (!Epi::AFTER_DRAIN) { if constexpr (Epi::ROWSCALE) { if (last) {
#pragma unroll
                for (int ai = 0; ai < 2; ++ai)
#pragma unroll
                    for (int m = 0; m < 4; ++m) rsc[ai][m] = E.rowscale[cur.pm * BM + ai * HALF + wr * 64 + m * 16 + fr]; } } }
            if constexpr (SP2) {
            PG8_LDB(B0, 0, 0); PG8_LDB(B1, 0, 1); PG8_SCHED; PG8_LDA(At, 0, 0); PG8_STAGE(PG8_SA(1, 1), a1 + hstep, voffA);
            PG8_WAIT_V(8); PG8_WAIT_L(0); PG8_BAR; PG8_MMA(0, 0, At, B0); PG8_MMA(0, 1, At, B1); PG8_BAR; PG8_SCHED;
            PG8_LDA(At, 0, 1); PG8_STAGE(PG8_SB(0, 0), b2, voffB); PG8_STAGE(PG8_SB(0, 1), b2 + hstep, voffB); PG8_STAGE(PG8_SA(0, 0), a2, voffA);
            PG8_WAIT_V(8); PG8_WAIT_L(0); PG8_BAR; PG8_MMA(1, 0, At, B0); PG8_MMA(1, 1, At, B1); PG8_BAR; PG8_SCHED;
            PG8_LDB(B0, 1, 0); PG8_LDB(B1, 1, 1); PG8_SCHED; PG8_LDA(At, 1, 0); PG8_STAGE(PG8_SA(0, 1), a2 + hstep, voffA);
            PG8_WAIT_V(8); PG8_WAIT_L(0); PG8_BAR; PG8_MMA(0, 0, At, B0); PG8_MMA(0, 1, At, B1); PG8_BAR; PG8_SCHED;
            PG8_LDA(At, 1, 1); PG8_STAGE(PG8_SB(1, 0), b3, voffB); PG8_STAGE(PG8_SB(1, 1), b3 + hstep, voffB); PG8_STAGE(PG8_SA(1, 0), a3, voffA);
            PG8_WAIT_V(8); PG8_WAIT_L(0); PG8_BAR; PG8_MMA(1, 0, At, B0); PG8_MMA(1, 1, At, B1); PG8_BAR; PG8_SCHED;
            } else {
            PG8_LDB(B0, 0, 0); PG8_SCHED; PG8_LDA(At, 0, 0); PG8_STAGE(PG8_SA(1, 1), a1 + hstep, voffA);
            PG8_WAIT_L(8); PG8_BAR; PG8_WAIT_L(0); PG8_MMA(0, 0, At, B0); PG8_BAR; PG8_SCHED;
            PG8_LDB(B1, 0, 1); PG8_STAGE(PG8_SB(0, 0), b2, voffB);
            PG8_BAR; PG8_WAIT_L(0); PG8_MMA(0, 1, At, B1); PG8_BAR;
            PG8_LDA(At, 0, 1); PG8_STAGE(PG8_SA(0, 0), a2, voffA);
            PG8_BAR; PG8_WAIT_L(0); PG8_MMA(1, 0, At, B0); PG8_BAR; PG8_SCHED;
            PG8_STAGE(PG8_SB(0, 1), b2 + hstep, voffB);
            PG8_WAIT_V(6); PG8_BAR; PG8_MMA(1, 1, At, B1); PG8_BAR;
            PG8_LDB(B0, 1, 0); PG8_SCHED; PG8_LDA(At, 1, 0); PG8_STAGE(PG8_SA(0, 1), a2 + hstep, voffA);
            PG8_WAIT_L(8); PG8_BAR; PG8_WAIT_L(0); PG8_MMA(0, 0, At, B0); PG8_BAR; PG8_SCHED;
            PG8_LDB(B1, 1, 1); PG8_STAGE(PG8_SB(1, 0), b3, voffB);
            PG8_BAR; PG8_WAIT_L(0); PG8_MMA(0, 1, At, B1); PG8_BAR;
            PG8_LDA(At, 1, 1); PG8_STAGE(PG8_SA(1, 0), a3, voffA);
            PG8_BAR; PG8_WAIT_L(0); PG8_MMA(1, 0, At, B0); PG8_BAR; PG8_SCHED;
            PG8_STAGE(PG8_SB(1, 1), b3 + hstep, voffB);
            PG8_WAIT_V(6); PG8_BAR; PG8_MMA(1, 1, At, B1); PG8_BAR;
            }
        }
        if constexpr (ALIGN_EPI) { if (wr == 0) PG8_BAR; }
        if constexpr (!Epi::AFTER_DRAIN) { E(acc, cur, wr, wc, fr, fq, rsc); S.done(cur); }
        if (!has_next) break;
#pragma unroll
        for (int a = 0; a < 2; ++a)
#pragma unroll
            for (int b = 0; b < 2; ++b)
#pragma unroll
                for (int m = 0; m < 4; ++m)
#pragma unroll
                    for (int n = 0; n < 2; ++n) acc[a][b][m][n] = (f32x4){0.f, 0.f, 0.f, 0.f};
        cur = nxt; cA = nA; cB = nB; ++ui;
        if constexpr (ALIGN_EPI) { if (wr == 1) PG8_BAR; }
    }
    PG8_WAIT_V(0);
    if constexpr (!ALIGN_EPI) { if (wr == 0) PG8_BAR; }
    PG8_BAR;
    if constexpr (Epi::AFTER_DRAIN) { E.fused(acc, cur, wr, wc, fr, fq, lds, wid, lane); S.done(cur); }
#undef PG8_SA
#undef PG8_SB
#undef PG8_STAGE
#undef PG8_LDA
#undef PG8_LDB
#undef PG8_MMA
#undef PG8_WAIT_V
#undef PG8_WAIT_L
#undef PG8_BAR
#undef PG8_SCHED
}
}


#define XB_TMO      128
#define XB_XCNT(j)  (256  + 64 * (j))
#define XB_XSUB(j)  (1280 + 64 * (j))
#define XB_XGEN(j)  (2304 + 64 * (j))
#define XB_TOP      3328
#define XB_TOPGEN   3392
#define XCD_BAR_WORDS 3456
#define XB_SPIN_CAP (1u << 18)
__device__ __forceinline__ unsigned xb_ld(unsigned* p)              { return __hip_atomic_load(p, __ATOMIC_RELAXED, __HIP_MEMORY_SCOPE_AGENT); }
__device__ __forceinline__ unsigned xb_add(unsigned* p, unsigned v) { return __hip_atomic_fetch_add(p, v, __ATOMIC_RELAXED, __HIP_MEMORY_SCOPE_AGENT); }
__device__ __forceinline__ unsigned xb_xcc_id() { return (unsigned)__builtin_amdgcn_s_getreg((3 << 11) | 20) & 0xFu; }
#define XB_SPIN(cond, bar) do { unsigned _sp = 0; while (cond) { __builtin_amdgcn_s_sleep(1); \
    if ((++_sp & 255u) == 0u) { if (xb_ld(&(bar)[XB_TMO])) break; if (_sp > XB_SPIN_CAP) { atomicAdd(&(bar)[XB_TMO], 1u); break; } } } } while (0)
struct XcdBarrier { unsigned* bar; unsigned x; volatile LAS unsigned* st; };
__device__ __forceinline__ XcdBarrier xcd_barrier_post(unsigned* bar, volatile LAS unsigned* st) {
    XcdBarrier b; b.bar = bar; b.x = xb_xcc_id(); b.st = st;
    if (threadIdx.x == 0) (void)xb_add(&bar[XB_XCNT(b.x)], 1u);
    return b;
}
__device__ __forceinline__ void xcd_barrier_complete(unsigned* bar, unsigned x, unsigned& nloc, unsigned& nx) {
    const unsigned G = gridDim.x * gridDim.y * gridDim.z;
    unsigned sum, cnt, mine, sp = 0u;
    for (;;) {
        sum = 0u; cnt = 0u; mine = 0u;
#pragma unroll
        for (unsigned j = 0; j < 16; ++j) { const unsigned c = xb_ld(&bar[XB_XCNT(j)]); sum += c; cnt += (c > 0u) ? 1u : 0u; mine = (j == x) ? c : mine; }
        if (sum == G) break;
        __builtin_amdgcn_s_sleep(1);
        if ((++sp & 255u) == 0u) { if (xb_ld(&bar[XB_TMO])) break; if (sp > XB_SPIN_CAP) { atomicAdd(&bar[XB_TMO], 1u); break; } }
    }
    nloc = mine > 0u ? mine : 1u; nx = cnt > 0u ? cnt : 1u;
}
__device__ __forceinline__ void xcd_barrier(const XcdBarrier& b) {
    asm volatile("s_waitcnt vmcnt(0)" ::: "memory");
    __syncthreads();
    if (threadIdx.x == 0) {
        unsigned* bar = b.bar;
        __builtin_amdgcn_s_waitcnt(0);
        unsigned nloc = b.st[0], nx = b.st[1];
        if (nloc == 0u) { xcd_barrier_complete(bar, b.x, nloc, nx); b.st[0] = nloc; b.st[1] = nx; }
        const unsigned old = xb_add(&bar[XB_XSUB(b.x)], 1u);
        const unsigned gen = old / nloc;
        if (old + 1u == (gen + 1u) * nloc) {
            __builtin_amdgcn_fence(__ATOMIC_RELEASE, "agent");
            asm volatile("s_waitcnt vmcnt(0)" ::: "memory");
            const unsigned og = xb_add(&bar[XB_TOP], 1u);
            const unsigned tg = og / nx;
            if (og + 1u == (tg + 1u) * nx) xb_add(&bar[XB_TOPGEN], 1u);
            else XB_SPIN(xb_ld(&bar[XB_TOPGEN]) == tg, bar);
            __builtin_amdgcn_fence(__ATOMIC_ACQUIRE, "agent");
            xb_add(&bar[XB_XGEN(b.x)], 1u);
            asm volatile("s_waitcnt vmcnt(0)" ::: "memory");
        } else {
            XB_SPIN(xb_ld(&bar[XB_XGEN(b.x)]) == gen, bar);
            __builtin_amdgcn_fence(__ATOMIC_ACQUIRE, "agent");
            asm volatile("s_waitcnt vmcnt(0)" ::: "memory");
        }
    }
    __syncthreads();
}

constexpr int DM = 1024, NBATCH = 16, SEQ = 2048, MPR = NBATCH * SEQ, DBATCH = 128, MREAL = MPR + DBATCH, MPAD = 33024;
constexpr int DIN = 5632, DFF = 4096, NHEAD = 16;
constexpr int C_Q = 0, C_K = 1024, C_V = 1280, C_U = 1536, C_G = 2560, C_GA = 3584, C_GR = 4608;
constexpr float EPS = 1e-6f;
constexpr size_t O_YP = 0, O_YS = 33554432, O_KWP = 33685504, O_VWP = 34209792, O_CP = 34734080, O_LP = 34783232,
                 O_KWS = 34799616, O_VWS = 38993920, O_CS = 43188224, O_LS = 43581440;
constexpr size_t MiB = 1u << 20;
constexpr size_t WS_WIN = MiB / 2, WS_WOUT = WS_WIN + 11 * MiB, WS_WUP = WS_WOUT + 2 * MiB, WS_WDN = WS_WUP + 8 * MiB;
constexpr size_t ROWB = (size_t)DM * 2;
constexpr size_t WS_XS = WS_WDN + 8 * MiB;
constexpr size_t WS_A = WS_XS + (size_t)MREAL * ROWB;
constexpr size_t WS_B = WS_A + (size_t)MREAL * ROWB;
constexpr size_t WS_PEAK = WS_B + (size_t)MREAL * DIN * 2;
constexpr size_t WS_H = WS_XS;
constexpr size_t WS_HN = 287 * MiB;
constexpr size_t WS_X1 = 352 * MiB;
constexpr size_t WS_MIXS = 416 * MiB;
constexpr size_t WS_RS2 = WS_MIXS + MiB / 2;
constexpr size_t WS_NEED = WS_PEAK;
static_assert(WS_H + (size_t)MREAL * DFF * 2 <= WS_HN && WS_HN + (size_t)MREAL * ROWB <= WS_X1 && WS_X1 + (size_t)MPR * ROWB <= WS_MIXS && WS_MIXS + 3 * MiB <= WS_PEAK && WS_B <= WS_HN, "d_ws map");
static_assert(WS_PEAK <= 512 * MiB, "fits the 512 MiB workspace");

constexpr int NWAVES = 8;
constexpr int LDS_BYTES = 147456;
constexpr int L_K = 0, L_VT = 36864, L_UC = 73728, L_WT = 108544, L_PAR = 126976, L_SEG = 129024, L_CAR = 133120, L_SMP = 133632;
constexpr int KST = 72, UST = 68;
constexpr int L_MISC = 147392;
static_assert(L_SMP + 8 * 1024 <= L_MISC && L_MISC + 8 <= LDS_BYTES, "LDS map");
constexpr size_t CTL_BYTES = 131072;
constexpr size_t WS_CNT = 16384, CNT_BANK = 128 * 64 * 4;
constexpr size_t WS_FLAG = WS_CNT + 3 * CNT_BANK;
constexpr size_t WS_RS = 262144;

struct Args { const float* in[22]; float* out; unsigned char* ws; };
enum { I_XP = 0, I_XS, I_CK, I_CV, I_SC, I_SL, I_WIN, I_WOUT, I_SINK, I_CW, I_CB, I_WA, I_BA, I_WX, I_BX, I_LAM, I_WUP, I_WDN, I_GPM, I_GQM, I_GPF, I_GQF };

__device__ __forceinline__ void p0_transpose_item(const float* W, int K, int N, bf16* WT, LAS float* scr, int item, int lane, const float* gk = nullptr) {
    const int nblk = N / 32, kb = item / nblk, nb = item % nblk, k0 = 64 * kb, n0 = 32 * nb;
    float wv[32];
#pragma unroll
    for (int i = 0; i < 32; ++i) { const int kk = 2 * i + (lane >> 5); wv[i] = W[(size_t)(k0 + kk) * N + n0 + (lane & 31)]; }
    if (gk) {
#pragma unroll
        for (int i = 0; i < 32; ++i) wv[i] *= gk[k0 + 2 * i + (lane >> 5)]; }
#pragma unroll
    for (int i = 0; i < 32; ++i) { const int kk = 2 * i + (lane >> 5); scr[kk * 33 + (lane & 31)] = wv[i]; }
    asm volatile("s_waitcnt lgkmcnt(0)" ::: "memory");
    const int c = lane & 7;
#pragma unroll
    for (int j = 0; j < 4; ++j) { const int n = (lane >> 3) + 8 * j; const LAS float* s = scr + (8 * c) * 33 + n;
        v4u o; o.x = pk2(s[0 * 33], s[1 * 33]); o.y = pk2(s[2 * 33], s[3 * 33]); o.z = pk2(s[4 * 33], s[5 * 33]); o.w = pk2(s[6 * 33], s[7 * 33]);
        *(v4u*)(WT + (size_t)(n0 + n) * K + k0 + 8 * c) = o; }
    asm volatile("s_waitcnt lgkmcnt(0)" ::: "memory");
}
__device__ __forceinline__ void rows2_to_bf16(const float* xa, const float* xb, bool has_b, bf16* oa, bf16* ob, float* rsa_out, float* rsb_out, int lane) {
    const f32x4* ra = (const f32x4*)xa + lane; const f32x4* rb = (const f32x4*)xb + lane;
    f32x4 va[4], vb[4]; float sa = 0.f, sb = 0.f;
#pragma unroll
    for (int j = 0; j < 4; ++j) { va[j] = ra[64 * j]; vb[j] = has_b ? rb[64 * j] : (f32x4){0.f, 0.f, 0.f, 0.f}; }
#pragma unroll
    for (int j = 0; j < 4; ++j) { sa += (va[j].x * va[j].x + va[j].y * va[j].y) + (va[j].z * va[j].z + va[j].w * va[j].w); sb += (vb[j].x * vb[j].x + vb[j].y * vb[j].y) + (vb[j].z * vb[j].z + vb[j].w * vb[j].w); }
#pragma unroll
    for (int o = 1; o < 64; o <<= 1) { sa += __shfl_xor(sa, o); sb += __shfl_xor(sb, o); }
    const float rsa = 1.0f / sqrtf(sa * (1.f / DM) + EPS), rsb = 1.0f / sqrtf(sb * (1.f / DM) + EPS);
    unsigned long long* o8a = (unsigned long long*)oa + lane; unsigned long long* o8b = (unsigned long long*)ob + lane;
#pragma unroll
    for (int j = 0; j < 4; ++j) { const f32x4 pa = va[j] * rsa, pb = vb[j] * rsb;
        o8a[64 * j] = (unsigned long long)pk2(pa.x, pa.y) | ((unsigned long long)pk2(pa.z, pa.w) << 32);
        if (has_b) o8b[64 * j] = (unsigned long long)pk2(pb.x, pb.y) | ((unsigned long long)pk2(pb.z, pb.w) << 32); }
    if (lane == 0) { *rsa_out = rsa; if (has_b) *rsb_out = rsb; }
}
__device__ __forceinline__ void p0_prologue(const Args& A, LAS unsigned char* lds, int G) {
    const int tid = opaque_tid(), lane = tid & 63, wave = __builtin_amdgcn_readfirstlane(tid >> 6);
    LAS float* scr = (LAS float*)(lds + wave * 16384);
    const int gw = blockIdx.x * NWAVES + wave, NGW = G * NWAVES;
    constexpr int I_1 = (DM / 64) * (DIN / 32), I_2 = (DM / 64) * (DM / 32), I_3 = (DM / 64) * (DFF / 32), I_4 = (DFF / 64) * (DM / 32);
    constexpr int NITEMS = I_1 + I_2 + I_3 + I_4;
    for (int it = gw; it < NITEMS; it += NGW) {
        int r = it;
        if (r < I_1) { p0_transpose_item(A.in[I_WIN], DM, DIN, (bf16*)(A.ws + WS_WIN), scr, r, lane, A.in[I_GPM]); continue; } r -= I_1;
        if (r < I_2) { p0_transpose_item(A.in[I_WOUT], DM, DM, (bf16*)(A.ws + WS_WOUT), scr, r, lane); continue; } r -= I_2;
        if (r < I_3) { p0_transpose_item(A.in[I_WUP], DM, DFF, (bf16*)(A.ws + WS_WUP), scr, r, lane, A.in[I_GPF]); continue; } r -= I_3;
        p0_transpose_item(A.in[I_WDN], DFF, DM, (bf16*)(A.ws + WS_WDN), scr, r, lane);
    }
    { const f32x4* ck = (const f32x4*)A.in[I_CK]; const f32x4* cv = (const f32x4*)A.in[I_CV]; f32x4* ok = (f32x4*)(A.out + O_KWS); f32x4* ov = (f32x4*)(A.out + O_VWS);
      const int NT = G * NWAVES * 64;
#pragma unroll 4
      for (int i = gw * 64 + lane; i < DBATCH * 127 * 64; i += NT) { const int bs = i / (127 * 64), r = i - bs * (127 * 64);
          ok[(size_t)bs * 8192 + r] = ck[(size_t)bs * 8192 + 64 + r]; ov[(size_t)bs * 8192 + r] = cv[(size_t)bs * 8192 + 64 + r]; } }
    bf16* XN = (bf16*)(A.ws + WS_XS);
    for (int m = gw; m < MREAL; m += 4 * NGW) {
        constexpr int NR = 4; f32x4 v[NR][4]; float ss[NR]; int mr[NR]; bool ok[NR];
#pragma unroll
        for (int r = 0; r < NR; ++r) { const int mm = m + r * NGW; ok[r] = mm < MREAL; mr[r] = ok[r] ? mm : m;
            const f32x4* src = (const f32x4*)((mr[r] < MPR) ? A.in[I_XP] + (size_t)mr[r] * DM : A.in[I_XS] + (size_t)(mr[r] - MPR) * DM) + lane;
#pragma unroll
            for (int j = 0; j < 4; ++j) v[r][j] = src[64 * j]; }
#pragma unroll
        for (int r = 0; r < NR; ++r) { float a = 0.f;
#pragma unroll
            for (int j = 0; j < 4; ++j) a += (v[r][j].x * v[r][j].x + v[r][j].y * v[r][j].y) + (v[r][j].z * v[r][j].z + v[r][j].w * v[r][j].w);
            ss[r] = a; }
#pragma unroll
        for (int o = 1; o < 64; o <<= 1) {
#pragma unroll
            for (int r = 0; r < NR; ++r) ss[r] += __shfl_xor(ss[r], o); }
#pragma unroll
        for (int r = 0; r < NR; ++r) { const float rs = 1.0f / sqrtf(ss[r] * (1.f / DM) + EPS);
            if (ok[r]) { unsigned long long* o8 = (unsigned long long*)(XN + (size_t)mr[r] * DM) + lane;
#pragma unroll
                for (int j = 0; j < 4; ++j) { const f32x4 p = v[r][j] * rs; o8[64 * j] = (unsigned long long)pk2(p.x, p.y) | ((unsigned long long)pk2(p.z, p.w) << 32); }
                if (lane == 0) ((float*)(A.ws + WS_RS))[mr[r]] = rs; } }
    }
}

#define MFMA16(a, b, c) __builtin_amdgcn_mfma_f32_16x16x32_bf16((a), (b), (c), 0, 0, 0)
#define LDS_FENCE() asm volatile("s_waitcnt lgkmcnt(0)" ::: "memory")

struct P2Regs { v4u k[2], v[2], u[5]; };
struct P2Cur { bf16x8 q[2]; v2u ga[4], gr[4], gb[4]; };
struct P2Off { unsigned k[2], v[2], u, q, gt; };
#define RAW_BARRIER() do { asm volatile("s_waitcnt lgkmcnt(0)" ::: "memory"); __builtin_amdgcn_s_barrier(); asm volatile("" ::: "memory"); } while (0)

__device__ __forceinline__ void p2_issue(const char* zc, const P2Off& O, P2Regs& R) {
#pragma unroll
    for (int it = 0; it < 2; ++it) R.k[it] = *(const v4u*)(zc + O.k[it]);
#pragma unroll
    for (int it = 0; it < 2; ++it) R.v[it] = *(const v4u*)(zc + O.v[it]);
}
__device__ __forceinline__ void p2_issue_u(const char* zc, const P2Off& O, P2Regs& R) {
#pragma unroll
    for (int i = 0; i < 5; ++i) R.u[i] = *(const v4u*)(zc + (long)(i - 3) * (DIN * 2) + O.u);
}
__device__ __forceinline__ void p2_issue_q(const char* zc, const P2Off& O, P2Cur& Q) {
    Q.q[0] = *(const bf16x8*)(zc + O.q); Q.q[1] = *(const bf16x8*)(zc + O.q + 64);
}
__device__ __forceinline__ void p2_issue_gates(const char* zc, const P2Off& O, P2Cur& Q) {
#pragma unroll
    for (int nt = 0; nt < 4; ++nt) {
        Q.ga[nt] = *(const v2u*)(zc + O.gt + 32 * nt); Q.gr[nt] = *(const v2u*)(zc + O.gt + 32 * nt + (C_GR - C_GA) * 2); Q.gb[nt] = *(const v2u*)(zc + (O.gt + 32 * nt - (unsigned)((C_GA - C_G) * 2))); }
}
__device__ __forceinline__ v2u merge4(v2u gav, v2u grv, v2u gbv, f32x4 o, f32x4 h) {
    constexpr float L2E = 1.4426950408889634f;
    const f32x4 ga = (f32x4){bflo(gav.x), bfhi(gav.x), bflo(gav.y), bfhi(gav.y)}, gr = (f32x4){bflo(grv.x), bfhi(grv.x), bflo(grv.y), bfhi(grv.y)}, gb = (f32x4){bflo(gbv.x), bfhi(gbv.x), bflo(gbv.y), bfhi(gbv.y)};
    const f32x4 xa = ga * (-L2E), xr = gr * (-L2E), xg = gb * (gb * gb * (-0.044715f * 1.5957691216057308f * L2E) + (-1.5957691216057308f * L2E));
    f32x4 ea, er, eg;
#pragma unroll
    for (int j = 0; j < 4; ++j) { ea[j] = __builtin_amdgcn_exp2f(xa[j]); er[j] = __builtin_amdgcn_exp2f(xr[j]); eg[j] = __builtin_amdgcn_exp2f(xg[j]); }
    const f32x4 da = ea + 1.0f, dr = (er + 1.0f) * (eg + 1.0f);
    f32x4 ra, rr;
#pragma unroll
    for (int j = 0; j < 4; ++j) { ra[j] = __builtin_amdgcn_rcpf(da[j]); rr[j] = __builtin_amdgcn_rcpf(dr[j]); }
    const f32x4 m = o * ra + gb * h * rr;
    return (v2u){pk2(m[0], m[1]), pk2(m[2], m[3])};
}
__device__ __forceinline__ P2Off p2_make_off(int tid, int wave, int n) {
    const int lane = tid & 63, g = lane >> 4, lq = lane & 15, kvh = n >> 2;
    P2Off O;
#pragma unroll
    for (int it = 0; it < 2; ++it) { const int i = tid + 512 * it, key = i >> 3, dg = i & 7; O.k[it] = (unsigned)(key * DIN + C_K + 64 * kvh + 8 * dg) * 2u; }
#pragma unroll
    for (int it = 0; it < 2; ++it) { const int i = tid + 512 * it, key = i >> 3, dg = i & 7; O.v[it] = (unsigned)(key * DIN + C_V + 64 * kvh + 8 * dg) * 2u; }
    const int ct0 = 16 * wave + 2 * (lane >> 3);
    O.u = (unsigned)(ct0 * DIN + C_U + 64 * n + 8 * (lane & 7)) * 2u;
    O.q = (unsigned)((16 * wave + lq) * DIN + 64 * n + C_Q + 8 * g) * 2u;
    O.gt = (unsigned)((16 * wave + lq) * DIN + 64 * n + C_GA + 4 * g) * 2u;
    return O;
}
__device__ __forceinline__ void p2_prompt_unit(const Args& A, LAS unsigned char* lds, int b, int n) {
    const int tid0 = opaque_tid();
    const int wave = __builtin_amdgcn_readfirstlane(tid0 >> 6);
    const int kvh = n >> 2;
    const bf16* Z = (const bf16*)(A.ws + WS_B);
    bf16* MG = (bf16*)(A.ws + WS_A);
    float* out = A.out;
    LAS bf16* Kl = (LAS bf16*)(lds + L_K); LAS bf16* Vt = (LAS bf16*)(lds + L_VT); LAS float* UC = (LAS float*)(lds + L_UC);
    LAS bf16* WT = (LAS bf16*)(lds + L_WT); LAS float* PAR = (LAS float*)(lds + L_PAR); LAS float* SEG = (LAS float*)(lds + L_SEG); LAS float* CAR = (LAS float*)(lds + L_CAR);
    const char* zu = (const char*)Z + (size_t)b * SEQ * DIN * 2;
    P2Regs R;
    { const int tid = tid0; const P2Off O = p2_make_off(tid, wave, n);
    p2_issue(zu, O, R); p2_issue_u(zu, O, R);
    if (tid < 64) { const int ch = 64 * n + tid;
#pragma unroll
        for (int i = 0; i < 4; ++i) PAR[i * 64 + tid] = A.in[I_CW][i * DM + ch];
        PAR[4 * 64 + tid] = A.in[I_CB][ch]; PAR[5 * 64 + tid] = -1.4426950408889634f * A.in[I_BA][ch]; PAR[6 * 64 + tid] = -1.4426950408889634f * A.in[I_BX][ch];
        PAR[7 * 64 + tid] = -8.0f * 1.4426950408889634f * log1pf(expf(-A.in[I_LAM][ch]));
        CAR[tid] = 0.f; CAR[64 + tid] = 0.f; }
    { const int c = tid >> 3, dg = tid & 7; const float* wa = A.in[I_WA] + (size_t)n * 4096 + c * 64 + 8 * dg; const float* wx = A.in[I_WX] + (size_t)n * 4096 + c * 64 + 8 * dg;
#pragma unroll
        for (int e = 0; e < 8; ++e) { WT[(8 * dg + e) * KST + c] = f2bf(wa[e]); WT[64 * KST + (8 * dg + e) * KST + c] = f2bf(wx[e]); } }
    for (int i = tid; i < 128 * KST * 2 / 16; i += 512) *(LAS v4u*)((LAS unsigned char*)Kl + 128 * KST * 2 + i * 16) = (v4u){0u, 0u, 0u, 0u};
    for (int i = tid; i < 128 * KST * 2 / 16; i += 512) *(LAS v4u*)((LAS unsigned char*)Vt + 128 * KST * 2 + i * 16) = (v4u){0u, 0u, 0u, 0u};
    RAW_BARRIER(); }
    const float sink = A.in[I_SINK][n];

    for (int c = 0; c < 16; ++c) {
        int tid = tid0; asm volatile("" : "+v"(tid));
        const int lane = tid & 63, g = lane >> 4, lq = lane & 15, ct0 = 16 * wave + 2 * (lane >> 3);
        const P2Off O = p2_make_off(tid, wave, n);
        const int m0 = b * SEQ + c * 128, hc = c & 1, hp = hc ^ 1;
        const char* zc = zu + (size_t)c * 128 * DIN * 2;
        P2Cur Q; p2_issue_q(zc, O, Q);
#pragma unroll
        for (int it = 0; it < 2; ++it) { const int i = tid + 512 * it, key = i >> 3, dg = i & 7;
            const v4u kv = R.k[it];
            *(LAS v4u*)(Kl + (hc * 128 + key) * KST + 8 * dg) = kv; }
#pragma unroll
        for (int it = 0; it < 2; ++it) { const int i = tid + 512 * it, key = i >> 3, dg = i & 7;
            *(LAS v4u*)(Vt + (hc * 128 + key) * KST + 8 * dg) = R.v[it]; }

        { const int tp = lane >> 3, c8 = 8 * (lane & 7), t0 = 16 * wave + 2 * tp;
          float a0[8], a1[8];
          { const f32x4 b0 = *(LAS f32x4*)(PAR + 4 * 64 + c8), b1 = *(LAS f32x4*)(PAR + 4 * 64 + c8 + 4);
            a0[0] = b0.x; a0[1] = b0.y; a0[2] = b0.z; a0[3] = b0.w; a0[4] = b1.x; a0[5] = b1.y; a0[6] = b1.z; a0[7] = b1.w;
#pragma unroll
            for (int e = 0; e < 8; ++e) a1[e] = a0[e]; }
#pragma unroll
          for (int i = 0; i < 5; ++i) { v4u uv = R.u[i];
              if (c == 0 && t0 - 3 + i < 0) uv = (v4u){0u, 0u, 0u, 0u};
              const float uf[8] = {bflo(uv.x), bfhi(uv.x), bflo(uv.y), bfhi(uv.y), bflo(uv.z), bfhi(uv.z), bflo(uv.w), bfhi(uv.w)};
              if (i < 4) { const f32x4 w0 = *(LAS f32x4*)(PAR + i * 64 + c8), w1 = *(LAS f32x4*)(PAR + i * 64 + c8 + 4);
                  const float wv[8] = {w0.x, w0.y, w0.z, w0.w, w1.x, w1.y, w1.z, w1.w};
#pragma unroll
                  for (int e = 0; e < 8; ++e) a0[e] += wv[e] * uf[e]; }
              if (i > 0) { const f32x4 w0 = *(LAS f32x4*)(PAR + (i - 1) * 64 + c8), w1 = *(LAS f32x4*)(PAR + (i - 1) * 64 + c8 + 4);
                  const float wv[8] = {w0.x, w0.y, w0.z, w0.w, w1.x, w1.y, w1.z, w1.w};
#pragma unroll
                  for (int e = 0; e < 8; ++e) a1[e] += wv[e] * uf[e]; } }
          *(LAS f32x4*)(UC + t0 * UST + c8) = (f32x4){a0[0], a0[1], a0[2], a0[3]}; *(LAS f32x4*)(UC + t0 * UST + c8 + 4) = (f32x4){a0[4], a0[5], a0[6], a0[7]};
          *(LAS f32x4*)(UC + (t0 + 1) * UST + c8) = (f32x4){a1[0], a1[1], a1[2], a1[3]}; *(LAS f32x4*)(UC + (t0 + 1) * UST + c8 + 4) = (f32x4){a1[4], a1[5], a1[6], a1[7]}; }
        p2_issue(zc + (size_t)128 * DIN * 2, O, R);
        asm volatile("" ::: "memory");
        f32x4 ga[4], gx[4];
#pragma unroll
        for (int nt = 0; nt < 4; ++nt) { ga[nt] = (f32x4){0.f, 0.f, 0.f, 0.f}; gx[nt] = (f32x4){0.f, 0.f, 0.f, 0.f}; }
#pragma unroll
        for (int ks = 0; ks < 2; ++ks) {
            const f32x4 u0 = *(LAS f32x4*)(UC + (16 * wave + lq) * UST + 32 * ks + 8 * g), u1 = *(LAS f32x4*)(UC + (16 * wave + lq) * UST + 32 * ks + 8 * g + 4);
            v4u ap; ap.x = pk2(u0.x, u0.y); ap.y = pk2(u0.z, u0.w); ap.z = pk2(u1.x, u1.y); ap.w = pk2(u1.z, u1.w);
            const bf16x8 af = __builtin_bit_cast(bf16x8, ap);
#pragma unroll
            for (int nt = 0; nt < 4; ++nt) {
                const bf16x8 ba = *(LAS bf16x8*)(WT + (16 * nt + lq) * KST + 32 * ks + 8 * g);
                const bf16x8 bx = *(LAS bf16x8*)(WT + 64 * KST + (16 * nt + lq) * KST + 32 * ks + 8 * g);
                ga[nt] = MFMA16(af, ba, ga[nt]); gx[nt] = MFMA16(af, bx, gx[nt]); } }
        float av[4][4], PA[4], PB[4];
#pragma unroll
        for (int nt = 0; nt < 4; ++nt) { const int ch = 16 * nt + lq;
            const float nba = PAR[5 * 64 + ch], nbx = PAR[6 * 64 + ch], spc = PAR[7 * 64 + ch];
            const f32x4 ea4 = ga[nt] * (-1.4426950408889634f) + nba, ex4 = gx[nt] * (-1.4426950408889634f) + nbx;
            f32x4 r4, i4, a4, m4, u4;
#pragma unroll
            for (int j = 0; j < 4; ++j) { r4[j] = __builtin_amdgcn_rcpf(1.0f + __builtin_amdgcn_exp2f(ea4[j])); i4[j] = __builtin_amdgcn_rcpf(1.0f + __builtin_amdgcn_exp2f(ex4[j]));
                u4[j] = UC[(16 * wave + 4 * g + j) * UST + ch]; }
            const f32x4 la4 = r4 * spc;
#pragma unroll
            for (int j = 0; j < 4; ++j) a4[j] = __builtin_amdgcn_exp2f(la4[j]);
            const f32x4 om = 1.0f - a4 * a4;
#pragma unroll
            for (int j = 0; j < 4; ++j) m4[j] = __builtin_amdgcn_sqrtf(om[j]);
            if (c == 0 && wave == 0 && g == 0) m4[0] = 1.0f;
            const f32x4 b4 = m4 * i4 * u4;
            float Aq = 1.f, Bq = 0.f;
#pragma unroll
            for (int j = 0; j < 4; ++j) { av[nt][j] = a4[j]; UC[(16 * wave + 4 * g + j) * UST + ch] = b4[j]; Bq = a4[j] * Bq + b4[j]; Aq = Aq * a4[j]; }
            float pa = 1.f, pb = 0.f, wa_ = 1.f, wb_ = 0.f;
#pragma unroll
            for (int k = 0; k < 4; ++k) { const float Ak = __shfl(Aq, lq + 16 * k), Bk = __shfl(Bq, lq + 16 * k);
                if (k < g) { pb = Ak * pb + Bk; pa = pa * Ak; }
                wb_ = Ak * wb_ + Bk; wa_ = wa_ * Ak; }
            PA[nt] = pa; PB[nt] = pb;
            if (g == 0) { SEG[wave * 64 + ch] = wa_; SEG[512 + wave * 64 + ch] = wb_; } }
        RAW_BARRIER();
        p2_issue_gates(zc, O, Q);
        p2_issue_u(zc + (size_t)128 * DIN * 2, O, R);
#pragma unroll
        for (int nt = 0; nt < 4; ++nt) { const int ch = 16 * nt + lq;
            float h = CAR[hc * 64 + ch];
#pragma unroll
            for (int w2 = 0; w2 < 7; ++w2) { const float sa = SEG[w2 * 64 + ch], sb = SEG[512 + w2 * 64 + ch]; h = (w2 < wave) ? sa * h + sb : h; }
            h = PA[nt] * h + PB[nt];
#pragma unroll
            for (int j = 0; j < 4; ++j) { const int t = 16 * wave + 4 * g + j; h = av[nt][j] * h + UC[t * UST + ch]; UC[t * UST + ch] = h; }
            if (wave == 7 && g == 3) CAR[hp * 64 + ch] = h; }
        asm volatile("" ::: "memory");
        {
            f32x4 sT[9];
#pragma unroll
            for (int jt = 0; jt < 9; ++jt) { const int kt = wave + jt; const int base = ((kt < 8) ? hp : hc) * 128 + (kt & 7) * 16;
                const LAS bf16* kp = Kl + (base + lq) * KST + 8 * g;
                const bf16x8 k0 = *(const LAS bf16x8*)kp, k1 = *(const LAS bf16x8*)(kp + 32);
                f32x4 acc = (f32x4){0.f, 0.f, 0.f, 0.f};
                acc = MFMA16(k0, Q.q[0], acc); acc = MFMA16(k1, Q.q[1], acc); sT[jt] = acc;
                }
            const int qi = 16 * wave + lq;
            float mx = -INFINITY;
#pragma unroll
            for (int jt = 0; jt < 9; ++jt)
#pragma unroll
                for (int j = 0; j < 4; ++j) { const int kj = 16 * (wave + jt) + 4 * g + j;
                    bool valid = (c > 0 || kj >= 128);
                    if (jt == 0) valid = valid && (kj >= qi);
                    if (jt == 8) valid = valid && (kj <= qi + 128);
                    const float sv = valid ? sT[jt][j] : -INFINITY; sT[jt][j] = sv; mx = fmaxf(mx, sv); }
            mx = fmaxf(mx, __shfl_xor(mx, 16)); mx = fmaxf(mx, __shfl_xor(mx, 32));
            constexpr float SC = 0.125f * 1.4426950408889634f;
            const float mxl = fmaxf(mx * SC, sink * 1.4426950408889634f);
            f32x4 sum4 = (f32x4){0.f, 0.f, 0.f, 0.f};
#pragma unroll
            for (int jt = 0; jt < 9; ++jt) { const f32x4 e4 = sT[jt] * SC - mxl; f32x4 p4;
#pragma unroll
                for (int j = 0; j < 4; ++j) p4[j] = __builtin_amdgcn_exp2f(e4[j]);
                sT[jt] = p4; sum4 += p4; }
            float sum = (sum4[0] + sum4[1]) + (sum4[2] + sum4[3]);
            sum += __shfl_xor(sum, 16); sum += __shfl_xor(sum, 32);
            const float inv = __builtin_amdgcn_rcpf(sum + __builtin_amdgcn_exp2f(sink * 1.4426950408889634f - mxl));
            f32x4 oT[4];
#pragma unroll
            for (int nt = 0; nt < 4; ++nt) oT[nt] = (f32x4){0.f, 0.f, 0.f, 0.f};
#pragma unroll
            for (int kk = 0; kk < 5; ++kk) { const int jt0 = 2 * kk, jt1 = (2 * kk + 1 < 9) ? 2 * kk + 1 : 8;
                v4u pp; pp.x = pk2(sT[jt0][0], sT[jt0][1]); pp.y = pk2(sT[jt0][2], sT[jt0][3]);
                if (kk < 4) { pp.z = pk2(sT[jt1][0], sT[jt1][1]); pp.w = pk2(sT[jt1][2], sT[jt1][3]); } else { pp.z = 0u; pp.w = 0u; }
                const bf16x8 pf = __builtin_bit_cast(bf16x8, pp);
                const int kt0 = wave + jt0; int kt1 = wave + 2 * kk + 1; kt1 = kt1 > 15 ? 15 : kt1;
                const int base0 = ((kt0 < 8) ? hp : hc) * 128 + (kt0 & 7) * 16, base1 = ((kt1 < 8) ? hp : hc) * 128 + (kt1 & 7) * 16;
#pragma unroll
                for (int nt = 0; nt < 4; ++nt) { const LAS bf16* vp = Vt + (4 * g + (lq >> 2)) * KST + 16 * nt + 4 * (lq & 3);
                    const s16x4 t0 = __builtin_amdgcn_ds_read_tr16_b64_v4i16((LAS s16x4*)(vp + base0 * KST)), t1 = __builtin_amdgcn_ds_read_tr16_b64_v4i16((LAS s16x4*)(vp + base1 * KST));
                    const v2u v0 = __builtin_bit_cast(v2u, t0), v1 = __builtin_bit_cast(v2u, t1);
                    const v4u vv = (v4u){v0.x, v0.y, v1.x, v1.y};
                    oT[nt] = MFMA16(__builtin_bit_cast(bf16x8, vv), pf, oT[nt]); } }
            const size_t row = (size_t)(m0 + 16 * wave + lq);
#pragma unroll
            for (int nt = 0; nt < 4; ++nt) { const int d0 = 16 * nt + 4 * g;
                const v2u gav = Q.ga[nt], grv = Q.gr[nt], gbv = Q.gb[nt];
                const f32x4 h4 = *(LAS f32x4*)(UC + (16 * wave + lq) * UST + d0);
                *(v2u*)(MG + row * DM + 64 * n + d0) = merge4(gav, grv, gbv, oT[nt] * inv, h4); }
        }
        RAW_BARRIER();
    }
    { const int mL = b * SEQ + 15 * 128; int tq = tid0; asm volatile("" : "+v"(tq));
      if (tq < 64) out[O_LP + (size_t)b * DM + 64 * n + tq] = CAR[tq];
      if (tq < 192) { const int j = tq >> 6, ch = tq & 63;
          out[O_CP + (size_t)(b * 3 + j) * DM + 64 * n + ch] = bf2f(Z[(size_t)(mL + 125 + j) * DIN + C_U + 64 * n + ch]); }
      {
          { const int i = tq; const int which = i >> 8, key = 32 * (n & 3) + ((i >> 3) & 31), dg = i & 7;
              const v4u kv = *(const v4u*)(Z + (size_t)(mL + key) * DIN + (which ? C_V : C_K) + 64 * kvh + 8 * dg);
              float* o = out + (which ? O_VWP : O_KWP) + ((size_t)(b * 128 + key) * 4 + kvh) * 64 + 8 * dg;
              *(f32x4*)o = (f32x4){bflo(kv.x), bfhi(kv.x), bflo(kv.y), bfhi(kv.y)}; *(f32x4*)(o + 4) = (f32x4){bflo(kv.z), bfhi(kv.z), bflo(kv.w), bfhi(kv.w)}; } }
      RAW_BARRIER(); }
}

__device__ __forceinline__ void p2_sample_item(const Args& A, LAS float* scr, int bs, int n, int lane) {
    const int kvh = n >> 2, cg_ = 64 * n + lane;
    const size_t row = (size_t)MPR + bs;
    const bf16* zr = (const bf16*)(A.ws + WS_B) + row * DIN;
    bf16* MG = (bf16*)(A.ws + WS_A);
    float* out = A.out;
    const float un = bf2f(zr[C_U + cg_]);
    const float* sc = A.in[I_SC] + (size_t)bs * 3 * DM + cg_;
    const float s0 = sc[0], s1 = sc[DM], s2 = sc[2 * DM];
    const float* cw = A.in[I_CW] + cg_;
    const float uc = A.in[I_CB][cg_] + cw[0] * s0 + cw[DM] * s1 + cw[2 * DM] * s2 + cw[3 * DM] * un;
    out[O_CS + ((size_t)bs * 3 + 0) * DM + cg_] = s1; out[O_CS + ((size_t)bs * 3 + 1) * DM + cg_] = s2; out[O_CS + ((size_t)bs * 3 + 2) * DM + cg_] = un;
    float ra = A.in[I_BA][cg_], rx = A.in[I_BX][cg_];
    const float* wa = A.in[I_WA] + (size_t)n * 4096 + lane; const float* wx = A.in[I_WX] + (size_t)n * 4096 + lane;
#pragma unroll 32
    for (int c = 0; c < 64; ++c) { const float ucc = __shfl(uc, c); ra += ucc * wa[c * 64]; rx += ucc * wx[c * 64]; }
    const float r = sigmoidf_(ra), ig = sigmoidf_(rx);
    const float sp = log1pf(expf(-A.in[I_LAM][cg_]));
    const float la = -8.0f * r * sp, a = __expf(la);
    const float mult = sqrtf(fmaxf(1.0f - __expf(2.0f * la), 0.f));
    const float h = a * A.in[I_SL][(size_t)bs * DM + cg_] + mult * ig * uc;
    out[O_LS + (size_t)bs * DM + cg_] = h;
    const float rnn = gelu_tanh(bf2f(zr[C_G + cg_])) * h;
    const float qv = bf2f(zr[C_Q + cg_]);
    const float knew = bf2f(zr[C_K + 64 * kvh + lane]), vnew = bf2f(zr[C_V + 64 * kvh + lane]);
    scr[lane] = qv;
    LDS_FENCE();
    const float* ck = A.in[I_CK] + ((size_t)(bs * 128 + lane) * 4 + kvh) * 64;
    float d0 = 0.f, d1 = 0.f;
#pragma unroll
    for (int dd = 0; dd < 16; ++dd) { const f32x4 q4 = *(LAS f32x4*)(scr + 4 * dd); const f32x4 ka = ((const f32x4*)ck)[dd], kb = ((const f32x4*)(ck + 64 * 256))[dd];
        d0 += (q4.x * ka.x + q4.y * ka.y) + (q4.z * ka.z + q4.w * ka.w); d1 += (q4.x * kb.x + q4.y * kb.y) + (q4.z * kb.z + q4.w * kb.w); }
    const float d2 = wave_sum(qv * knew);
    const float sink = A.in[I_SINK][n];
    const float sa = d0 * 0.125f, sb = d1 * 0.125f, sn = d2 * 0.125f;
    float mx = wave_max(fmaxf(sa, sb)); mx = fmaxf(mx, fmaxf(sn, sink));
    const float p0 = __expf(sa - mx), p1 = __expf(sb - mx), p2 = __expf(sn - mx);
    const float den = wave_sum(p0 + p1) + p2 + __expf(sink - mx);
    scr[64 + lane] = p0; scr[128 + lane] = p1;
    LDS_FENCE();
    float o = p2 * vnew;
    const float* cv = A.in[I_CV] + ((size_t)(bs * 128) * 4 + kvh) * 64 + lane;
#pragma unroll 32
    for (int j = 0; j < 128; ++j) o += scr[64 + j] * cv[(size_t)j * 256];
    o = o / den;
    const float merged = sigmoidf_(bf2f(zr[C_GA + cg_])) * o + sigmoidf_(bf2f(zr[C_GR + cg_])) * rnn;
    MG[row * DM + cg_] = f2bf(merged);
    LDS_FENCE();
    if ((n & 3) == 0) { out[O_KWS + ((size_t)(bs * 128 + 127) * 4 + kvh) * 64 + lane] = knew; out[O_VWS + ((size_t)(bs * 128 + 127) * 4 + kvh) * 64 + lane] = vnew; }
}

template <class EpiS>
__device__ __forceinline__ void skinny_items(LAS unsigned char* lds, const bf16* Am, int lda, const bf16* Bt, int ldb, int n_tiles, int ksplit, int item_lo, int item_hi, int which, int G, const EpiS& epi) {
    const int tid = opaque_tid(), lane = tid & 63, wave = __builtin_amdgcn_readfirstlane(tid >> 6), lq = lane & 15, g = lane >> 4;
    if (which >= 0 && (int)(blockIdx.x & 1) != which) return;
    const int first = (which < 0) ? (int)blockIdx.x : (int)(blockIdx.x >> 1), step = (which < 0) ? G : (G >> 1);
    const int n_pairs = n_tiles >> 1;
    LAS f32x4* red = (LAS f32x4*)lds;
    for (int it = item_lo + first; it < item_hi; it += step) {
        const int np = it % n_pairs, kq = it / n_pairs;
        const int kb = kq * 1024 + wave * 128 + 8 * g;
        const bf16* ap = Am + (size_t)lq * lda + kb;
        const bf16* bp = Bt + (size_t)(32 * np + lq) * ldb + kb;
        f32x4 acc[8][2];
#pragma unroll
        for (int rt = 0; rt < 8; ++rt) { acc[rt][0] = (f32x4){0.f, 0.f, 0.f, 0.f}; acc[rt][1] = (f32x4){0.f, 0.f, 0.f, 0.f}; }
        bf16x8 bfr[4][2], afr[4][8];
#pragma unroll
        for (int ks = 0; ks < 4; ++ks) { bfr[ks][0] = *(const bf16x8*)(bp + 32 * ks); bfr[ks][1] = *(const bf16x8*)(bp + (size_t)16 * ldb + 32 * ks);
#pragma unroll
            for (int rt = 0; rt < 8; ++rt) afr[ks][rt] = *(const bf16x8*)(ap + (size_t)(16 * rt) * lda + 32 * ks); }
#pragma unroll
        for (int ks = 0; ks < 4; ++ks)
#pragma unroll
            for (int rt = 0; rt < 8; ++rt) { acc[rt][0] = MFMA16(bfr[ks][0], afr[ks][rt], acc[rt][0]); acc[rt][1] = MFMA16(bfr[ks][1], afr[ks][rt], acc[rt][1]); }
        RAW_BARRIER();
#pragma unroll
        for (int rt = 0; rt < 8; ++rt) { red[(wave * 16 + rt * 2 + 0) * 64 + lane] = acc[rt][0]; red[(wave * 16 + rt * 2 + 1) * 64 + lane] = acc[rt][1]; }
        RAW_BARRIER();
#pragma unroll
        for (int ct = 0; ct < 2; ++ct) { f32x4 sum = red[(wave * 2 + ct) * 64 + lane];
#pragma unroll
            for (int w2 = 1; w2 < 8; ++w2) sum += red[(w2 * 16 + wave * 2 + ct) * 64 + lane];
            epi(16 * wave + lq, 16 * (2 * np + ct) + 4 * g, kq, sum); }
    }
    RAW_BARRIER();
}

__device__ __forceinline__ void p3b_rows(const Args& A, int G, int wg_lo) {
    if ((int)blockIdx.x < wg_lo || (int)blockIdx.x >= wg_lo + 16) return;
    const int tid = opaque_tid(), lane = tid & 63, wave = __builtin_amdgcn_readfirstlane(tid >> 6);
    const int gw = ((int)blockIdx.x - wg_lo) * NWAVES + wave, NGW = 16 * NWAVES;
    const float* MIX = (const float*)(A.ws + WS_MIXS) - (size_t)MPR * DM; bf16* HN = (bf16*)(A.ws + WS_HN);
    const f32x4* g1 = (const f32x4*)A.in[I_GQM] + lane;
    for (int m = MPR + gw; m < MREAL; m += NGW) {
        unsigned long long* o8 = (unsigned long long*)(HN + (size_t)m * DM) + lane;
        const f32x4* mr = (const f32x4*)(MIX + (size_t)m * DM) + lane;
        const f32x4* xr = (const f32x4*)((m < MPR) ? A.in[I_XP] + (size_t)m * DM : A.in[I_XS] + (size_t)(m - MPR) * DM) + lane;
        f32x4* orow = (f32x4*)(A.out + (size_t)m * DM) + lane;
        f32x4 v[4], xv[4]; float s = 0.f;
#pragma unroll
        for (int j = 0; j < 4; ++j) { v[j] = mr[64 * j]; xv[j] = xr[64 * j]; s += (v[j].x * v[j].x + v[j].y * v[j].y) + (v[j].z * v[j].z + v[j].w * v[j].w); }
        const float rstd = 1.0f / sqrtf(wave_sum(s) * (1.f / DM) + EPS);
        float s2 = 0.f;
#pragma unroll
        for (int j = 0; j < 4; ++j) { xv[j] = xv[j] + v[j] * rstd * g1[64 * j]; orow[64 * j] = xv[j];
            s2 += (xv[j].x * xv[j].x + xv[j].y * xv[j].y) + (xv[j].z * xv[j].z + xv[j].w * xv[j].w); }
        const float rstd2 = 1.0f / sqrtf(wave_sum(s2) * (1.f / DM) + EPS);
        if (lane == 0) ((float*)(A.ws + WS_RS2))[m] = rstd2;
#pragma unroll
        for (int j = 0; j < 4; ++j) { const f32x4 o = xv[j];
            o8[64 * j] = (unsigned long long)pk2(o.x, o.y) | ((unsigned long long)pk2(o.z, o.w) << 32); }
    }
    asm volatile("s_waitcnt vmcnt(0)" ::: "memory"); RAW_BARRIER();
    if (tid == 0) { __builtin_amdgcn_fence(__ATOMIC_RELEASE, "agent"); __hip_atomic_fetch_add((unsigned*)(A.ws + WS_FLAG), 1u, __ATOMIC_RELAXED, __HIP_MEMORY_SCOPE_AGENT); }
}
__device__ __forceinline__ void wait_flag(unsigned* flag, unsigned want) {
    if (threadIdx.x == 0) { unsigned sp = 0; while (__hip_atomic_load(flag, __ATOMIC_RELAXED, __HIP_MEMORY_SCOPE_AGENT) < want) { __builtin_amdgcn_s_sleep(2); if (++sp > (1u << 22)) break; }
        __builtin_amdgcn_fence(__ATOMIC_ACQUIRE, "agent"); asm volatile("s_waitcnt vmcnt(0)" ::: "memory"); }
    RAW_BARRIER();
}
__device__ __forceinline__ void p5b_rows(const Args& A, int G) {
    if ((blockIdx.x & 1) || blockIdx.x >= 32) return;
    wait_flag((unsigned*)(A.ws + WS_FLAG) + 64, 128u);
    const int tid = opaque_tid(), lane = tid & 63, wave = __builtin_amdgcn_readfirstlane(tid >> 6);
    const int gw = (int)(blockIdx.x >> 1) * NWAVES + wave, NGW = 16 * NWAVES;
    const float* F = (const float*)(A.ws + WS_A);
    const f32x4* g1 = (const f32x4*)A.in[I_GQF] + lane;
    for (int m = MPR + gw; m < MREAL; m += NGW) {
        const f32x4* fr = (const f32x4*)(F + (size_t)m * DM) + lane;
        f32x4* orow = (f32x4*)(A.out + (size_t)m * DM) + lane;
        f32x4 v[4], xv[4]; float s = 0.f;
        if (m >= MPR) { const f32x4* pr = (const f32x4*)((const float*)(A.ws + WS_WOUT) + (size_t)(m - MPR) * DM) + lane;
#pragma unroll
            for (int j = 0; j < 4; ++j) v[j] = (pr[64 * j] + pr[64 * j + DBATCH * DM / 4]) + (pr[64 * j + 2 * (DBATCH * DM / 4)] + pr[64 * j + 3 * (DBATCH * DM / 4)]); }
        else {
#pragma unroll
            for (int j = 0; j < 4; ++j) v[j] = fr[64 * j]; }
#pragma unroll
        for (int j = 0; j < 4; ++j) { xv[j] = orow[64 * j]; s += (v[j].x * v[j].x + v[j].y * v[j].y) + (v[j].z * v[j].z + v[j].w * v[j].w); }
        const float rstd = 1.0f / sqrtf(wave_sum(s) * (1.f / DM) + EPS);
#pragma unroll
        for (int j = 0; j < 4; ++j) orow[64 * j] = xv[j] + v[j] * rstd * g1[64 * j];
    }
}

__global__ void __launch_bounds__(NWAVES * 64, 2) mega_fwd(Args args) {
    extern __shared__ __attribute__((aligned(16))) unsigned char lds_raw[];
    cg::grid_group grid = cg::this_grid();
    LAS unsigned char* lds = (LAS unsigned char*)lds_raw;
    const int G = gridDim.x;
    unsigned char* ws = args.ws;
    if (threadIdx.x == 0) { ((volatile LAS unsigned*)(lds + L_MISC))[0] = 0u; ((volatile LAS unsigned*)(lds + L_MISC))[1] = 0u; }
    __syncthreads();
    const XcdBarrier bar = xcd_barrier_post((unsigned*)ws, (volatile LAS unsigned*)(lds + L_MISC));

    p0_prologue(args, lds, G);
    if (G == 0x7fffffff) grid.sync();
    xcd_barrier(bar);
    { pg8::Gemm g{(const bf16*)(ws + WS_XS), (const bf16*)(ws + WS_WIN), MPAD, DIN, DM}; pg8::StaticOrder S; S.init(MPR, DIN, G, (int)blockIdx.x);
      pg8::EpiBf16<0> E{(bf16*)(ws + WS_B), DIN, nullptr};
      pg8::gemm_phase<pg8::EpiBf16<0>, pg8::StaticOrder, true, true>(lds, g, S, E);
      bf16* Zs = (bf16*)(ws + WS_B) + (size_t)MPR * DIN;
      skinny_items(lds, (const bf16*)(ws + WS_XS) + (size_t)MPR * DM, DM, (const bf16*)(ws + WS_WIN), DM, DIN / 16, 1, 0, DIN / 32, -1, G,
                   [Zs](int r, int c, int, const f32x4& a) { *(v2u*)(Zs + (size_t)r * DIN + c) = (v2u){pk2(a[0], a[1]), pk2(a[2], a[3])}; }); }
    xcd_barrier(bar);
    for (int u0 = blockIdx.x; u0 < NBATCH * NHEAD; u0 += G) { const int u = (G == 256) ? (((u0 & 7) * 2 + ((u0 >> 3) >> 4)) << 4) + ((u0 >> 3) & 15) : u0;
        p2_prompt_unit(args, lds, u >> 4, u & 15); }
    { const int tid = opaque_tid(), lane = tid & 63, wave = __builtin_amdgcn_readfirstlane(tid >> 6);
      for (int it = blockIdx.x * NWAVES + wave; it < DBATCH * NHEAD; it += G * NWAVES) p2_sample_item(args, (LAS float*)(lds + L_SMP + wave * 1024), it >> 4, it & 15, lane); }
    xcd_barrier(bar);
    { pg8::Gemm g{(const bf16*)(ws + WS_A), (const bf16*)(ws + WS_WOUT), MPR, DM, DM}; pg8::StaticOrder S; S.init(MPR, DM, G, (int)blockIdx.x);
      pg8::PanelRms st1{(float*)(ws + WS_MIXS + 1 * MiB), (unsigned*)(ws + WS_CNT)}; pg8::PanelPublish st2{(float*)(ws + WS_MIXS + 2 * MiB), (unsigned*)(ws + WS_CNT + CNT_BANK), (float*)(ws + WS_RS2)};
      pg8::EpiRmsResRms E{(const bf16*)(ws + WS_XS), (const float*)(ws + WS_RS), (bf16*)(ws + WS_X1), args.in[I_GQM], st1, st2};
      float* Ms = (float*)(ws + WS_MIXS);
      auto epis = [Ms](int r, int c, int, const f32x4& a) { *(f32x4*)(Ms + (size_t)r * DM + c) = a; };
      skinny_items(lds, (const bf16*)(ws + WS_A) + (size_t)MPR * DM, DM, (const bf16*)(ws + WS_WOUT), DM, DM / 16, 1, 0, DM / 32, 1, G, epis);
      for (int i = 0; i < 2; ++i) { pg8::OneUnit U; U.valid = S.next(i, U.u);
          pg8::gemm_phase<pg8::EpiRmsResRms, pg8::OneUnit, false, true>(lds, g, U, E);
          RAW_BARRIER(); }
    }
    xcd_barrier(bar);
    p3b_rows(args, G, 128);
    { pg8::Gemm g{(const bf16*)(ws + WS_X1), (const bf16*)(ws + WS_WUP), MPAD, DFF, DM}; pg8::StaticOrder S; S.init(MPR, DFF, G, (int)blockIdx.x);
      pg8::EpiBf16<3> E{(bf16*)(ws + WS_H), DFF, (const float*)(ws + WS_RS2)};
      pg8::gemm_phase<pg8::EpiBf16<3>, pg8::StaticOrder, true, true>(lds, g, S, E);
      if (blockIdx.x < DFF / 32) wait_flag((unsigned*)(ws + WS_FLAG), 16u);
      bf16* Hs = (bf16*)(ws + WS_H) + (size_t)MPR * DFF;
      skinny_items(lds, (const bf16*)(ws + WS_HN) + (size_t)MPR * DM, DM, (const bf16*)(ws + WS_WUP), DM, DFF / 16, 1, 0, DFF / 32, -1, G,
                   [Hs, rs2s = (const float*)(ws + WS_RS2) + MPR](int r, int c, int, const f32x4& a) { const float q = rs2s[r], q2 = q * q;
                       const float x0 = fmaxf(a[0], 0.f), x1 = fmaxf(a[1], 0.f), x2 = fmaxf(a[2], 0.f), x3 = fmaxf(a[3], 0.f);
                       *(v2u*)(Hs + (size_t)r * DFF + c) = (v2u){pk2(x0 * x0 * q2, x1 * x1 * q2), pk2(x2 * x2 * q2, x3 * x3 * q2)}; }); }
    xcd_barrier(bar);
    { pg8::Gemm g{(const bf16*)(ws + WS_H), (const bf16*)(ws + WS_WDN), MPR, DM, DFF}; pg8::StaticOrder S; S.init(MPR, DM, G, (int)blockIdx.x);
      pg8::PanelRms st{(float*)(ws + WS_MIXS + 1 * MiB), (unsigned*)(ws + WS_CNT + 2 * CNT_BANK)};
      pg8::EpiRmsRes E{(const bf16*)(ws + WS_X1), args.out, args.in[I_GQF], st};
      float* Fp = (float*)(ws + WS_WOUT);
      auto epis = [Fp](int r, int c, int kq, const f32x4& a) { *(f32x4*)(Fp + ((size_t)kq * DBATCH + r) * DM + c) = a; };
      skinny_items(lds, (const bf16*)(ws + WS_H) + (size_t)MPR * DFF, DFF, (const bf16*)(ws + WS_WDN), DFF, DM / 16, 4, 0, 4 * (DM / 32), 1, G, epis);
      if (blockIdx.x & 1) { asm volatile("s_waitcnt vmcnt(0)" ::: "memory"); RAW_BARRIER();
          if (threadIdx.x == 0) { __builtin_amdgcn_fence(__ATOMIC_RELEASE, "agent"); __hip_atomic_fetch_add((unsigned*)(ws + WS_FLAG) + 64, 1u, __ATOMIC_RELAXED, __HIP_MEMORY_SCOPE_AGENT); } }
      for (int i = 1; i >= 0; --i) { pg8::OneUnit U; U.valid = S.next(i, U.u);
          pg8::gemm_phase<pg8::EpiRmsRes, pg8::OneUnit, false, true>(lds, g, U, E);
          RAW_BARRIER(); }
    }
    p5b_rows(args, G);
}

extern "C" void kernel_launch(void* const* d_in, const int* in_sizes, int n_in, void* d_out, int out_size, void* d_ws, size_t ws_size, hipStream_t stream) {
    static int grid = 0;
    if (grid == 0) {
        if (n_in != 22 || ws_size < WS_NEED) { fprintf(stderr, "kernel_launch: unexpected n_in %d or ws_size %zu (< %zu)\n", n_in, ws_size, (size_t)WS_NEED); grid = -1; return; }
        int dev = 0, cus = 0, per_cu = 0;
        (void)hipGetDevice(&dev);
        (void)hipDeviceGetAttribute(&cus, hipDeviceAttributeMultiprocessorCount, dev);
        (void)hipFuncSetAttribute((const void*)mega_fwd, hipFuncAttributeMaxDynamicSharedMemorySize, LDS_BYTES);
        (void)hipOccupancyMaxActiveBlocksPerMultiprocessor(&per_cu, (const void*)mega_fwd, NWAVES * 64, LDS_BYTES);
        if (per_cu < 1) { fprintf(stderr, "kernel_launch: occupancy query gave %d\n", per_cu); per_cu = 1; }
        (void)hipGetLastError();
        grid = cus * per_cu;
    }
    if (grid < 0) return;
    Args a{};
    for (int i = 0; i < 22; ++i) a.in[i] = (const float*)d_in[i];
    a.out = (float*)d_out; a.ws = (unsigned char*)d_ws;
    if (hipMemsetAsync(d_ws, 0, CTL_BYTES, stream) != hipSuccess) { fprintf(stderr, "kernel_launch: memset failed\n"); return; }
    void* kargs[] = {&a};
    hipError_t e = hipLaunchCooperativeKernel((const void*)mega_fwd, dim3(grid), dim3(NWAVES * 64), kargs, LDS_BYTES, stream);
    if (e != hipSuccess) fprintf(stderr, "cooperative launch failed: %s (grid %d)\n", hipGetErrorString(e), grid);
}
```

```cpp
#include <hip/hip_runtime.h>
#include <hip/hip_cooperative_groups.h>
#include <cstdio>
#include <cstdint>
namespace cg = cooperative_groups;

#define LAS __attribute__((address_space(3)))
typedef unsigned short bf16;
typedef unsigned v4u __attribute__((ext_vector_type(4)));
typedef unsigned v2u __attribute__((ext_vector_type(2)));
typedef float f32x4 __attribute__((ext_vector_type(4)));
typedef float f32x2 __attribute__((ext_vector_type(2)));
typedef short bf16x8 __attribute__((ext_vector_type(8)));
typedef short s16x4 __attribute__((ext_vector_type(4)));
typedef __bf16 b16x2 __attribute__((ext_vector_type(2)));

__device__ __forceinline__ unsigned pk2(float lo, float hi) { f32x2 v = {lo, hi}; b16x2 r = __builtin_convertvector(v, b16x2); return __builtin_bit_cast(unsigned, r); }
__device__ __forceinline__ bf16 f2bf(float f) { return (bf16)(pk2(f, 0.f) & 0xffffu); }
__device__ __forceinline__ float bf2f(bf16 h) { return __uint_as_float((unsigned)h << 16); }
__device__ __forceinline__ float bflo(unsigned w) { return __uint_as_float(w << 16); }
__device__ __forceinline__ float bfhi(unsigned w) { return __uint_as_float(w & 0xffff0000u); }
__device__ __forceinline__ float sigmoidf_(float x) { return __builtin_amdgcn_rcpf(1.0f + __expf(-x)); }
__device__ __forceinline__ float gelu_tanh(float x) { const float y = 0.7978845608028654f * (x + 0.044715f * x * x * x); return x * sigmoidf_(2.0f * y); }
__device__ __forceinline__ int opaque_tid() { int t = threadIdx.x; asm volatile("" : "+v"(t)); return t; }
__device__ __forceinline__ float wave_sum(float v) {
#pragma unroll
    for (int o = 1; o < 64; o <<= 1) v += __shfl_xor(v, o);
    return v;
}
__device__ __forceinline__ float wave_max(float v) {
#pragma unroll
    for (int o = 1; o < 64; o <<= 1) v = fmaxf(v, __shfl_xor(v, o));
    return v;
}

namespace pg8 {
#define PG8_LAS __attribute__((address_space(3)))
typedef unsigned short bf16_t;
typedef short bf16x8 __attribute__((ext_vector_type(8)));
typedef float f32x4 __attribute__((ext_vector_type(4)));
typedef unsigned u32x4 __attribute__((ext_vector_type(4)));
constexpr int BM = 256, BK = 64, HALF = 128, HTB = HALF * BK * 2, STAGE_BYTES = 8 * HTB, NXCD = 8, WGM = 8;

__host__ __device__ __forceinline__ int lds_byte(int r, int c) { const int st = (r >> 4) * 2 + (c >> 5), rr = r & 15, cc = c & 31, ob = rr * 64 + cc * 2; return st * 1024 + (ob ^ (((ob >> 9) & 1) << 5)); }
__host__ __device__ __forceinline__ void stage_rc(int b, int& R, int& C) { const int st = b / 1024, sb = b % 1024, swz = sb ^ (((sb >> 9) & 1) << 5); R = (st >> 1) * 16 + swz / 64; C = (st & 1) * 32 + (swz % 64) / 2; }
__host__ __device__ __forceinline__ int perm32(int rho) { const int n = rho >> 4, i = rho & 15; return 8 * (i >> 2) + 4 * n + (i & 3); }

struct Unit { int pm, pn; };
struct Gemm { const bf16_t* A; const bf16_t* Bt; int M, N, K; };

struct StaticOrder {
    int nM, nN, nwg, G, c;
    __host__ __device__ void init(int M, int N, int G_, int c_) { nM = M / BM; nN = N / BM; nwg = nM * nN; G = G_; c = c_; }
    __host__ __device__ bool next(int i, Unit& u) const {
        const long L = (long)i * G + c; if (L >= nwg) return false;
        int wgid = (int)L; { const int q = nwg / NXCD, r = nwg % NXCD, xcd = wgid % NXCD, off = wgid / NXCD; wgid = (xcd < r ? xcd * (q + 1) : r * (q + 1) + (xcd - r) * q) + off; }
        const int nig = WGM * nN, gid = wgid / nig, fm = gid * WGM, gsz = (nM - fm) < WGM ? (nM - fm) : WGM;
        u.pm = fm + ((wgid % nig) % gsz); u.pn = (wgid % nig) / gsz; return true;
    }
    __device__ __forceinline__ void a_ready(const Unit&) const {}
    __device__ __forceinline__ void done(const Unit&) const {}
};

template <int ACT  > struct EpiBf16 {
    static constexpr bool PERM = true, AFTER_DRAIN = false, ROWSCALE = (ACT == 3);
    bf16_t* O; int ldc; const float* rowscale;
    __device__ __forceinline__ void operator()(const f32x4 (&acc)[2][2][4][2], const Unit& u, int wr, int wc, int fr, int fq, const float (&rsc)[2][4]) const {
        const int row0 = u.pm * BM + wr * 64 + fr; const int col0 = u.pn * BM + wc * 32 + 8 * fq;
#pragma unroll
        for (int ai = 0; ai < 2; ++ai)
#pragma unroll
            for (int m = 0; m < 4; ++m) { bf16_t* rowp = O + (size_t)(row0 + ai * HALF + m * 16) * ldc + col0;
                const float q2 = (ACT == 3) ? rsc[ai][m] * rsc[ai][m] : 1.0f;
#pragma unroll
                for (int bj = 0; bj < 2; ++bj) { f32x4 v0 = acc[ai][bj][m][0], v1 = acc[ai][bj][m][1];
                    if (ACT >= 2) {
#pragma unroll
                        for (int e = 0; e < 4; ++e) { const float a = fmaxf(v0[e], 0.f), b = fmaxf(v1[e], 0.f); v0[e] = a * a * q2; v1[e] = b * b * q2; } }
                    u32x4 w; w.x = pk2(v0[0], v0[1]); w.y = pk2(v0[2], v0[3]); w.z = pk2(v1[0], v1[1]); w.w = pk2(v1[2], v1[3]);
                    *(u32x4*)(rowp + bj * HALF) = w; } }
    }
};
struct EpiF32 {
    static constexpr bool PERM = false, AFTER_DRAIN = false, ROWSCALE = false;
    float* O; int ldc;
    __device__ __forceinline__ void operator()(const f32x4 (&acc)[2][2][4][2], const Unit& u, int wr, int wc, int fr, int fq, const float (&rsc)[2][4]) const {
        const int row0 = u.pm * BM + wr * 64 + fr; const int col0 = u.pn * BM + wc * 32 + 4 * fq;
#pragma unroll
        for (int ai = 0; ai < 2; ++ai)
#pragma unroll
            for (int m = 0; m < 4; ++m) { float* rowp = O + (size_t)(row0 + ai * HALF + m * 16) * ldc + col0;
#pragma unroll
                for (int bj = 0; bj < 2; ++bj)
#pragma unroll
                    for (int n = 0; n < 2; ++n) *(f32x4*)(rowp + bj * HALF + n * 16) = acc[ai][bj][m][n]; }
    }
};


struct OneUnit { Unit u; bool valid;
    __device__ __forceinline__ bool next(int i, Unit& o) const { if (i == 0 && valid) { o = u; return true; } return false; }
    __device__ __forceinline__ void a_ready(const Unit&) const {}
    __device__ __forceinline__ void done(const Unit&) const {} };
struct PanelRms {
    float* xbuf;
    unsigned* cnt;
    __device__ __forceinline__ void run(const f32x4 (&v)[2][2][4][2], const Unit& u, int wr, int wc, int fr, int fq, PG8_LAS unsigned char* lds, int wid, int lane) const {
        PG8_LAS float* P = (PG8_LAS float*)lds;
        PG8_LAS float* S = (PG8_LAS float*)(lds + 4096);
#pragma unroll
        for (int ai = 0; ai < 2; ++ai)
#pragma unroll
            for (int m = 0; m < 4; ++m) { float s = 0.f;
#pragma unroll
                for (int bj = 0; bj < 2; ++bj)
#pragma unroll
                    for (int n = 0; n < 2; ++n) { const f32x4 x = v[ai][bj][m][n]; s += (x[0] * x[0] + x[1] * x[1]) + (x[2] * x[2] + x[3] * x[3]); }
                s += __shfl_xor(s, 16); s += __shfl_xor(s, 32);
                if (fq == 0) P[(ai * HALF + wr * 64 + m * 16 + fr) * 4 + wc] = s; }
        asm volatile("s_waitcnt lgkmcnt(0)" ::: "memory"); __builtin_amdgcn_s_barrier(); asm volatile("" ::: "memory");
        const int row = wid * 32 + (lane & 31);
        if (lane < 32) { const f32x4 p = *(const PG8_LAS f32x4*)(P + row * 4);
            __hip_atomic_store(xbuf + ((size_t)(u.pm * BM + row) * 4 + u.pn), (p[0] + p[1]) + (p[2] + p[3]), __ATOMIC_RELAXED, __HIP_MEMORY_SCOPE_AGENT); }
        asm volatile("s_waitcnt vmcnt(0)" ::: "memory");
        if (lane == 0) __hip_atomic_fetch_add(cnt + 64 * u.pm, 1u, __ATOMIC_RELAXED, __HIP_MEMORY_SCOPE_AGENT);
        if (wid == 0) { unsigned sp = 0;
            while ((unsigned)__builtin_amdgcn_readfirstlane(__hip_atomic_load(cnt + 64 * u.pm, __ATOMIC_RELAXED, __HIP_MEMORY_SCOPE_AGENT)) < 32u) { __builtin_amdgcn_s_sleep(2); if (++sp > (1u << 22)) break; }
            __builtin_amdgcn_fence(__ATOMIC_ACQUIRE, "agent"); }
        asm volatile("s_waitcnt vmcnt(0) lgkmcnt(0)" ::: "memory"); __builtin_amdgcn_s_barrier(); asm volatile("" ::: "memory");
        if (lane < 32) { const float* slot = xbuf + (size_t)(u.pm * BM + row) * 4; float t = 0.f;
#pragma unroll
            for (int k = 0; k < 4; ++k) t += __hip_atomic_load(slot + k, __ATOMIC_RELAXED, __HIP_MEMORY_SCOPE_AGENT);
            S[row] = 1.0f / sqrtf(t * (1.0f / 1024.0f) + 1e-6f); }
        asm volatile("s_waitcnt lgkmcnt(0)" ::: "memory"); __builtin_amdgcn_s_barrier(); asm volatile("" ::: "memory");
    }
};
struct PanelPublish {
    float* xbuf; unsigned* cnt; float* rs2;
    __device__ __forceinline__ void run(const f32x4 (&v)[2][2][4][2], const Unit& u, int wr, int wc, int fr, int fq, PG8_LAS unsigned char* lds, int wid, int lane) const {
        PG8_LAS float* P = (PG8_LAS float*)(lds + 8192);
#pragma unroll
        for (int ai = 0; ai < 2; ++ai)
#pragma unroll
            for (int m = 0; m < 4; ++m) { float s = 0.f;
#pragma unroll
                for (int bj = 0; bj < 2; ++bj)
#pragma unroll
                    for (int n = 0; n < 2; ++n) { const f32x4 x = v[ai][bj][m][n]; s += (x[0] * x[0] + x[1] * x[1]) + (x[2] * x[2] + x[3] * x[3]); }
                s += __shfl_xor(s, 16); s += __shfl_xor(s, 32);
                if (fq == 0) P[(ai * HALF + wr * 64 + m * 16 + fr) * 4 + wc] = s; }
        asm volatile("s_waitcnt lgkmcnt(0)" ::: "memory"); __builtin_amdgcn_s_barrier(); asm volatile("" ::: "memory");
        const int row = wid * 32 + (lane & 31);
        if (lane < 32) { const f32x4 p = *(const PG8_LAS f32x4*)(P + row * 4);
            __hip_atomic_store(xbuf + ((size_t)(u.pm * BM + row) * 4 + u.pn), (p[0] + p[1]) + (p[2] + p[3]), __ATOMIC_RELAXED, __HIP_MEMORY_SCOPE_AGENT); }
        asm volatile("s_waitcnt vmcnt(0)" ::: "memory");
        unsigned old = 0u; if (lane == 0) old = __hip_atomic_fetch_add(cnt + 64 * u.pm, 1u, __ATOMIC_RELAXED, __HIP_MEMORY_SCOPE_AGENT);
        old = (unsigned)__builtin_amdgcn_readfirstlane(old);
        if (old == 31u) {
            __builtin_amdgcn_fence(__ATOMIC_ACQUIRE, "agent");
#pragma unroll
            for (int rr = 0; rr < 4; ++rr) { const int r = lane + 64 * rr; const float* slot = xbuf + (size_t)(u.pm * BM + r) * 4; float t = 0.f;
#pragma unroll
                for (int k = 0; k < 4; ++k) t += __hip_atomic_load(slot + k, __ATOMIC_RELAXED, __HIP_MEMORY_SCOPE_AGENT);
                rs2[u.pm * BM + r] = 1.0f / sqrtf(t * (1.0f / 1024.0f) + 1e-6f); } }
    }
};
struct EpiRmsResRms {
    static constexpr bool PERM = true, AFTER_DRAIN = true, ROWSCALE = false;
    const bf16_t* xs; const float* rsx; bf16_t* x1b; const float* g1; PanelRms st1; PanelPublish st2;
    __device__ __forceinline__ void fused(f32x4 (&acc)[2][2][4][2], const Unit& u, int wr, int wc, int fr, int fq, PG8_LAS unsigned char* lds, int wid, int lane) const {
        const PG8_LAS float* S = (const PG8_LAS float*)(lds + 4096);
        const int col0 = u.pn * BM + wc * 32 + 8 * fq;
        u32x4 pre[2][4][2]; float irs[2][4];
#pragma unroll
        for (int ai = 0; ai < 2; ++ai)
#pragma unroll
            for (int m = 0; m < 4; ++m) { const int grow = u.pm * BM + ai * HALF + wr * 64 + m * 16 + fr; const size_t off = (size_t)grow * 1024 + col0;
                irs[ai][m] = rsx[grow];
#pragma unroll
                for (int bj = 0; bj < 2; ++bj) pre[ai][m][bj] = *(const u32x4*)(xs + off + bj * HALF); }
        st1.run(acc, u, wr, wc, fr, fq, lds, wid, lane);
        f32x4 gv[2][2];
#pragma unroll
        for (int bj = 0; bj < 2; ++bj)
#pragma unroll
            for (int n = 0; n < 2; ++n) gv[bj][n] = *(const f32x4*)(g1 + col0 + bj * HALF + n * 4);
#pragma unroll
        for (int ai = 0; ai < 2; ++ai)
#pragma unroll
            for (int m = 0; m < 4; ++m) { const int r = ai * HALF + wr * 64 + m * 16 + fr; const float rs = S[r]; const float ix = 1.0f / irs[ai][m];
#pragma unroll
                for (int bj = 0; bj < 2; ++bj) { const u32x4 p = pre[ai][m][bj];
                    const f32x4 b0 = (f32x4){__uint_as_float(p.x << 16), __uint_as_float(p.x & 0xffff0000u), __uint_as_float(p.y << 16), __uint_as_float(p.y & 0xffff0000u)};
                    const f32x4 b1 = (f32x4){__uint_as_float(p.z << 16), __uint_as_float(p.z & 0xffff0000u), __uint_as_float(p.w << 16), __uint_as_float(p.w & 0xffff0000u)};
                    const f32x4 a0 = b0 * ix + acc[ai][bj][m][0] * rs * gv[bj][0], a1 = b1 * ix + acc[ai][bj][m][1] * rs * gv[bj][1];
                    acc[ai][bj][m][0] = a0; acc[ai][bj][m][1] = a1;
                    u32x4 w; w.x = pk2(a0[0], a0[1]); w.y = pk2(a0[2], a0[3]); w.z = pk2(a1[0], a1[1]); w.w = pk2(a1[2], a1[3]);
                    *(u32x4*)(x1b + (size_t)(u.pm * BM + r) * 1024 + col0 + bj * HALF) = w; }
                asm volatile("" : "+v"(acc[ai][0][m][0]), "+v"(acc[ai][0][m][1]), "+v"(acc[ai][1][m][0]), "+v"(acc[ai][1][m][1])); }
        asm volatile("" ::: "memory");
        st2.run(acc, u, wr, wc, fr, fq, lds, wid, lane);
    }
};
struct EpiRmsRes {
    static constexpr bool PERM = true, AFTER_DRAIN = true, ROWSCALE = false;
    const bf16_t* x1b; float* out; const float* g1; PanelRms st;
    __device__ __forceinline__ void fused(f32x4 (&acc)[2][2][4][2], const Unit& u, int wr, int wc, int fr, int fq, PG8_LAS unsigned char* lds, int wid, int lane) const {
        const PG8_LAS float* S = (const PG8_LAS float*)(lds + 4096);
        const int col0 = u.pn * BM + wc * 32 + 8 * fq;
        u32x4 pre[2][4][2];
#pragma unroll
        for (int ai = 0; ai < 2; ++ai)
#pragma unroll
            for (int m = 0; m < 4; ++m) { const size_t off = (size_t)(u.pm * BM + ai * HALF + wr * 64 + m * 16 + fr) * 1024 + col0;
#pragma unroll
                for (int bj = 0; bj < 2; ++bj) pre[ai][m][bj] = *(const u32x4*)(x1b + off + bj * HALF); }
        f32x4 gv[2][2];
#pragma unroll
        for (int bj = 0; bj < 2; ++bj)
#pragma unroll
            for (int n = 0; n < 2; ++n) gv[bj][n] = *(const f32x4*)(g1 + col0 + bj * HALF + n * 4);
        st.run(acc, u, wr, wc, fr, fq, lds, wid, lane);
#pragma unroll
        for (int ai = 0; ai < 2; ++ai)
#pragma unroll
            for (int m = 0; m < 4; ++m) { const int r = ai * HALF + wr * 64 + m * 16 + fr; const float rs = S[r]; const size_t off = (size_t)(u.pm * BM + r) * 1024 + col0;
#pragma unroll
                for (int bj = 0; bj < 2; ++bj) { const u32x4 p = pre[ai][m][bj];
                    const f32x4 b0 = (f32x4){__uint_as_float(p.x << 16), __uint_as_float(p.x & 0xffff0000u), __uint_as_float(p.y << 16), __uint_as_float(p.y & 0xffff0000u)};
                    const f32x4 b1 = (f32x4){__uint_as_float(p.z << 16), __uint_as_float(p.z & 0xffff0000u), __uint_as_float(p.w << 16), __uint_as_float(p.w & 0xffff0000u)};
                    *(f32x4*)(out + off + bj * HALF) = b0 + acc[ai][bj][m][0] * rs * gv[bj][0];
                    *(f32x4*)(out + off + bj * HALF + 4) = b1 + acc[ai][bj][m][1] * rs * gv[bj][1]; } }
    }
};

template <class Epi, class Sched, bool ALIGN_EPI = false, bool SP2 = false>
__device__ __forceinline__ void gemm_phase(PG8_LAS unsigned char* lds, const Gemm g, const Sched& S, const Epi& E) {
    const int tid = opaque_tid(), wid = __builtin_amdgcn_readfirstlane(tid >> 6), lane = tid & 63, wr = wid >> 2, wc = wid & 3, fr = lane & 15, fq = lane >> 4;
    const int K = g.K, nt = K / BK;
    unsigned voffA[2], voffB[2];
#pragma unroll
    for (int i = 0; i < 2; ++i) { int R, C; stage_rc(tid * 16 + i * 8192, R, C); const int Rb = Epi::PERM ? ((R & ~31) + perm32(R & 31)) : R;
        voffA[i] = (unsigned)(R * K + C) * 2u; voffB[i] = (unsigned)(Rb * K + C) * 2u; }
    const size_t kstep = (size_t)(BK * 2);
    const size_t hstep = (size_t)HALF * K * 2;
    const size_t tstep = 2 * hstep;
    const unsigned ldsw = (unsigned)wid * 1024u;
    const int aoff = lds_byte(wr * 64 + fr, fq * 8), boff = lds_byte(wc * 32 + fr, fq * 8);
#define PG8_SA(b, h) (((b) * 2 + (h)) * HTB)
#define PG8_SB(b, h) ((4 + (b) * 2 + (h)) * HTB)
#define PG8_STAGE(bufoff, gbase, voff) do { _Pragma("unroll") for (int _i = 0; _i < 2; ++_i) \
        __builtin_amdgcn_global_load_lds((const unsigned*)((const char*)(gbase) + (voff)[_i]), (PG8_LAS unsigned*)(lds + (bufoff) + ldsw + _i * 8192), 16, 0, 0); } while (0)
#define PG8_LDA(dst, b, h) do { _Pragma("unroll") for (int m = 0; m < 4; ++m) _Pragma("unroll") for (int k = 0; k < 2; ++k) dst[m][k] = *(const PG8_LAS bf16x8*)(lds + PG8_SA(b, h) + aoff + m * 2048 + k * 1024); } while (0)
#define PG8_LDB(dst, b, h) do { _Pragma("unroll") for (int n = 0; n < 2; ++n) _Pragma("unroll") for (int k = 0; k < 2; ++k) dst[n][k] = *(const PG8_LAS bf16x8*)(lds + PG8_SB(b, h) + boff + n * 2048 + k * 1024); } while (0)
#define PG8_MMA(ai, bj, At, Bt) do { __builtin_amdgcn_s_setprio(1); _Pragma("unroll") for (int m = 0; m < 4; ++m) _Pragma("unroll") for (int n = 0; n < 2; ++n) _Pragma("unroll") for (int k = 0; k < 2; ++k) \
        acc[ai][bj][m][n] = __builtin_amdgcn_mfma_f32_16x16x32_bf16(Bt[n][k], At[m][k], acc[ai][bj][m][n], 0, 0, 0); __builtin_amdgcn_s_setprio(0); } while (0)
#define PG8_WAIT_V(n) asm volatile("s_waitcnt vmcnt(" #n ")" ::: "memory")
#define PG8_WAIT_L(n) asm volatile("s_waitcnt lgkmcnt(" #n ")" ::: "memory")
#define PG8_BAR __builtin_amdgcn_s_barrier()
#define PG8_SCHED __builtin_amdgcn_sched_barrier(0)
    Unit cur, nxt; int ui = 0;
    if (!S.next(0, cur)) return;
    f32x4 acc[2][2][4][2];
#pragma unroll
    for (int a = 0; a < 2; ++a)
#pragma unroll
        for (int b = 0; b < 2; ++b)
#pragma unroll
            for (int m = 0; m < 4; ++m)
#pragma unroll
                for (int n = 0; n < 2; ++n) acc[a][b][m][n] = (f32x4){0.f, 0.f, 0.f, 0.f};
    bf16x8 At[4][2], B0[2][2], B1[2][2];
    float rsc[2][4] = {{1.f, 1.f, 1.f, 1.f}, {1.f, 1.f, 1.f, 1.f}};
    const char* cA = (const char*)g.A + (size_t)cur.pm * tstep; const char* cB = (const char*)g.Bt + (size_t)cur.pn * tstep;
    S.a_ready(cur);
    if constexpr (SP2) {
        PG8_STAGE(PG8_SB(0, 0), cB, voffB); PG8_STAGE(PG8_SB(0, 1), cB + hstep, voffB); PG8_STAGE(PG8_SA(0, 0), cA, voffA); PG8_STAGE(PG8_SA(0, 1), cA + hstep, voffA);
        if (wr == 1) PG8_BAR;
        PG8_WAIT_V(2); PG8_BAR;
        PG8_STAGE(PG8_SB(1, 0), cB + kstep, voffB); PG8_STAGE(PG8_SA(1, 0), cA + kstep, voffA); PG8_STAGE(PG8_SB(1, 1), cB + hstep + kstep, voffB);
        PG8_WAIT_V(6); PG8_BAR;
    } else {
        PG8_STAGE(PG8_SB(0, 0), cB, voffB); PG8_STAGE(PG8_SA(0, 0), cA, voffA); PG8_STAGE(PG8_SB(0, 1), cB + hstep, voffB); PG8_STAGE(PG8_SA(0, 1), cA + hstep, voffA);
        if (wr == 1) PG8_BAR;
        PG8_WAIT_V(4); PG8_BAR;
        PG8_STAGE(PG8_SB(1, 0), cB + kstep, voffB); PG8_STAGE(PG8_SA(1, 0), cA + kstep, voffA); PG8_STAGE(PG8_SB(1, 1), cB + hstep + kstep, voffB);
        PG8_WAIT_V(6); PG8_BAR;
    }
    for (;;) {
        const bool has_next = S.next(ui + 1, nxt);
        const char* nA = has_next ? (const char*)g.A + (size_t)nxt.pm * tstep : cA; const char* nB = has_next ? (const char*)g.Bt + (size_t)nxt.pn * tstep : cB;
        for (int t = 0; t < nt; t += 2) {
            const bool last = (t == nt - 2);
            const char* a1 = cA + (size_t)(t + 1) * kstep;
            const char* a2 = last ? nA : cA + (size_t)(t + 2) * kstep; const char* b2 = last ? nB : cB + (size_t)(t + 2) * kstep;
            const char* a3 = a2 + kstep; const char* b3 = b2 + kstep;
            if (last && has_next) S.a_ready(nxt);
            if constexpr (!Epi::AFTER_DRAIN) { if constexpr (Epi::ROWSCALE) { if (last) {
#pragma unroll
                for (int ai = 0; ai < 2; ++ai)
#pragma unroll
                    for (int m = 0; m < 4; ++m) rsc[ai][m] = E.rowscale[cur.pm * BM + ai * HALF + wr * 64 + m * 16 + fr]; } } }
            if constexpr (SP2) {
            PG8_LDB(B0, 0, 0); PG8_LDB(B1, 0, 1); PG8_SCHED; PG8_LDA(At, 0, 0); PG8_STAGE(PG8_SA(1, 1), a1 + hstep, voffA);
            PG8_WAIT_V(8); PG8_WAIT_L(0); PG8_BAR; PG8_MMA(0, 0, At, B0); PG8_MMA(0, 1, At, B1); PG8_BAR; PG8_SCHED;
            PG8_LDA(At, 0, 1); PG8_STAGE(PG8_SB(0, 0), b2, voffB); PG8_STAGE(PG8_SB(0, 1), b2 + hstep, voffB); PG8_STAGE(PG8_SA(0, 0), a2, voffA);
            PG8_WAIT_V(8); PG8_WAIT_L(0); PG8_BAR; PG8_MMA(1, 0, At, B0); PG8_MMA(1, 1, At, B1); PG8_BAR; PG8_SCHED;
            PG8_LDB(B0, 1, 0); PG8_LDB(B1, 1, 1); PG8_SCHED; PG8_LDA(At, 1, 0); PG8_STAGE(PG8_SA(0, 1), a2 + hstep, voffA);
            PG8_WAIT_V(8); PG8_WAIT_L(0); PG8_BAR; PG8_MMA(0, 0, At, B0); PG8_MMA(0, 1, At, B1); PG8_BAR; PG8_SCHED;
            PG8_LDA(At, 1, 1); PG8_STAGE(PG8_SB(1, 0), b3, voffB); PG8_STAGE(PG8_SB(1, 1), b3 + hstep, voffB); PG8_STAGE(PG8_SA(1, 0), a3, voffA);
            PG8_WAIT_V(8); PG8_WAIT_L(0); PG8_BAR; PG8_MMA(1, 0, At, B0); PG8_MMA(1, 1, At, B1); PG8_BAR; PG8_SCHED;
            } else {
            PG8_LDB(B0, 0, 0); PG8_SCHED; PG8_LDA(At, 0, 0); PG8_STAGE(PG8_SA(1, 1), a1 + hstep, voffA);
            PG8_WAIT_L(8); PG8_BAR; PG8_WAIT_L(0); PG8_MMA(0, 0, At, B0); PG8_BAR; PG8_SCHED;
            PG8_LDB(B1, 0, 1); PG8_STAGE(PG8_SB(0, 0), b2, voffB);
            PG8_BAR; PG8_WAIT_L(0); PG8_MMA(0, 1, At, B1); PG8_BAR;
            PG8_LDA(At, 0, 1); PG8_STAGE(PG8_SA(0, 0), a2, voffA);
            PG8_BAR; PG8_WAIT_L(0); PG8_MMA(1, 0, At, B0); PG8_BAR; PG8_SCHED;
            PG8_STAGE(PG8_SB(0, 1), b2 + hstep, voffB);
            PG8_WAIT_V(6); PG8_BAR; PG8_MMA(1, 1, At, B1); PG8_BAR;
            PG8_LDB(B0, 1, 0); PG8_SCHED; PG8_LDA(At, 1, 0); PG8_STAGE(PG8_SA(0, 1), a2 + hstep, voffA);
            PG8_WAIT_L(8); PG8_BAR; PG8_WAIT_L(0); PG8_MMA(0, 0, At, B0); PG8_BAR; PG8_SCHED;
            PG8_LDB(B1, 1, 1); PG8_STAGE(PG8_SB(1, 0), b3, voffB);
            PG8_BAR; PG8_WAIT_L(0); PG8_MMA(0, 1, At, B1); PG8_BAR;
            PG8_LDA(At, 1, 1); PG8_STAGE(PG8_SA(1, 0), a3, voffA);
            PG8_BAR; PG8_WAIT_L(0); PG8_MMA(1, 0, At, B0); PG8_BAR; PG8_SCHED;
            PG8_STAGE(PG8_SB(1, 1), b3 + hstep, voffB);
            PG8_WAIT_V(6); PG8_BAR; PG8_MMA(1, 1, At, B1); PG8_BAR;
            }
        }
        if constexpr (ALIGN_EPI) { if (wr == 0) PG8_BAR; }
        if constexpr (!Epi::AFTER_DRAIN) { E(acc, cur, wr, wc, fr, fq, rsc); S.done(cur); }
        if (!has_next) break;
#pragma unroll
        for (int a = 0; a < 2; ++a)
#pragma unroll
            for (int b = 0; b < 2; ++b)
#pragma unroll
                for (int m = 0; m < 4; ++m)
#pragma unroll
                    for (int n = 0; n < 2; ++n) acc[a][b][m][n] = (f32x4){0.f, 0.f, 0.f, 0.f};
        cur = nxt; cA = nA; cB = nB; ++ui;
        if constexpr (ALIGN_EPI) { if (wr == 1) PG8_BAR; }
    }
    PG8_WAIT_V(0);
    if constexpr (!ALIGN_EPI) { if (wr == 0) PG8_BAR; }
    PG8_BAR;
    if constexpr (Epi::AFTER_DRAIN) { E.fused(acc, cur, wr, wc, fr, fq, lds, wid, lane); S.done(cur); }
#undef PG8_SA
#undef PG8_SB
#undef PG8_STAGE
#undef PG8_LDA
#undef PG8_LDB
#undef PG8_MMA
#undef PG8_WAIT_V
#undef PG8_WAIT_L
#undef PG8_BAR
#undef PG8_SCHED
}
}


#define XB_TMO      128
#define XB_XCNT(j)  (256  + 64 * (j))
#define XB_XSUB(j)  (1280 + 64 * (j))
#define XB_XGEN(j)  (2304 + 64 * (j))
#define XB_TOP      3328
#define XB_TOPGEN   3392
#define XCD_BAR_WORDS 3456
#define XB_SPIN_CAP (1u << 18)
__device__ __forceinline__ unsigned xb_ld(unsigned* p)              { return __hip_atomic_load(p, __ATOMIC_RELAXED, __HIP_MEMORY_SCOPE_AGENT); }
__device__ __forceinline__ unsigned xb_add(unsigned* p, unsigned v) { return __hip_atomic_fetch_add(p, v, __ATOMIC_RELAXED, __HIP_MEMORY_SCOPE_AGENT); }
__device__ __forceinline__ unsigned xb_xcc_id() { return (unsigned)__builtin_amdgcn_s_getreg((3 << 11) | 20) & 0xFu; }
#define XB_SPIN(cond, bar) do { unsigned _sp = 0; while (cond) { __builtin_amdgcn_s_sleep(1); \
    if ((++_sp & 255u) == 0u) { if (xb_ld(&(bar)[XB_TMO])) break; if (_sp > XB_SPIN_CAP) { atomicAdd(&(bar)[XB_TMO], 1u); break; } } } } while (0)
struct XcdBarrier { unsigned* bar; unsigned x; volatile LAS unsigned* st; };
__device__ __forceinline__ XcdBarrier xcd_barrier_post(unsigned* bar, volatile LAS unsigned* st) {
    XcdBarrier b; b.bar = bar; b.x = xb_xcc_id(); b.st = st;
    if (threadIdx.x == 0) (void)xb_add(&bar[XB_XCNT(b.x)], 1u);
    return b;
}
__device__ __forceinline__ void xcd_barrier_complete(unsigned* bar, unsigned x, unsigned& nloc, unsigned& nx) {
    const unsigned G = gridDim.x * gridDim.y * gridDim.z;
    unsigned sum, cnt, mine, sp = 0u;
    for (;;) {
        sum = 0u; cnt = 0u; mine = 0u;
#pragma unroll
        for (unsigned j = 0; j < 16; ++j) { const unsigned c = xb_ld(&bar[XB_XCNT(j)]); sum += c; cnt += (c > 0u) ? 1u : 0u; mine = (j == x) ? c : mine; }
        if (sum == G) break;
        __builtin_amdgcn_s_sleep(1);
        if ((++sp & 255u) == 0u) { if (xb_ld(&bar[XB_TMO])) break; if (sp > XB_SPIN_CAP) { atomicAdd(&bar[XB_TMO], 1u); break; } }
    }
    nloc = mine > 0u ? mine : 1u; nx = cnt > 0u ? cnt : 1u;
}
__device__ __forceinline__ void xcd_barrier(const XcdBarrier& b) {
    asm volatile("s_waitcnt vmcnt(0)" ::: "memory");
    __syncthreads();
    if (threadIdx.x == 0) {
        unsigned* bar = b.bar;
        __builtin_amdgcn_s_waitcnt(0);
        unsigned nloc = b.st[0], nx = b.st[1];
        if (nloc == 0u) { xcd_barrier_complete(bar, b.x, nloc, nx); b.st[0] = nloc; b.st[1] = nx; }
        const unsigned old = xb_add(&bar[XB_XSUB(b.x)], 1u);
        const unsigned gen = old / nloc;
        if (old + 1u == (gen + 1u) * nloc) {
            __builtin_amdgcn_fence(__ATOMIC_RELEASE, "agent");
            asm volatile("s_waitcnt vmcnt(0)" ::: "memory");
            const unsigned og = xb_add(&bar[XB_TOP], 1u);
            const unsigned tg = og / nx;
            if (og + 1u == (tg + 1u) * nx) xb_add(&bar[XB_TOPGEN], 1u);
            else XB_SPIN(xb_ld(&bar[XB_TOPGEN]) == tg, bar);
            __builtin_amdgcn_fence(__ATOMIC_ACQUIRE, "agent");
            xb_add(&bar[XB_XGEN(b.x)], 1u);
            asm volatile("s_waitcnt vmcnt(0)" ::: "memory");
        } else {
            XB_SPIN(xb_ld(&bar[XB_XGEN(b.x)]) == gen, bar);
            __builtin_amdgcn_fence(__ATOMIC_ACQUIRE, "agent");
            asm volatile("s_waitcnt vmcnt(0)" ::: "memory");
        }
    }
    __syncthreads();
}

constexpr int DM = 1024, NBATCH = 16, SEQ = 2048, MPR = NBATCH * SEQ, DBATCH = 128, MREAL = MPR + DBATCH, MPAD = 33024;
constexpr int DIN = 5632, DFF = 4096, NHEAD = 16;
constexpr int C_Q = 0, C_K = 1024, C_V = 1280, C_U = 1536, C_G = 2560, C_GA = 3584, C_GR = 4608;
constexpr float EPS = 1e-6f;
constexpr size_t O_YP = 0, O_YS = 33554432, O_KWP = 33685504, O_VWP = 34209792, O_CP = 34734080, O_LP = 34783232,
                 O_KWS = 34799616, O_VWS = 38993920, O_CS = 43188224, O_LS = 43581440;
constexpr size_t MiB = 1u << 20;
constexpr size_t WS_WIN = MiB / 2, WS_WOUT = WS_WIN + 11 * MiB, WS_WUP = WS_WOUT + 2 * MiB, WS_WDN = WS_WUP + 8 * MiB;
constexpr size_t ROWB = (size_t)DM * 2;
constexpr size_t WS_XS = WS_WDN + 8 * MiB;
constexpr size_t WS_A = WS_XS + (size_t)MREAL * ROWB;
constexpr size_t WS_B = WS_A + (size_t)MREAL * ROWB;
constexpr size_t WS_PEAK = WS_B + (size_t)MREAL * DIN * 2;
constexpr size_t WS_H = WS_XS;
constexpr size_t WS_HN = 287 * MiB;
constexpr size_t WS_X1 = 352 * MiB;
constexpr size_t WS_MIXS = 416 * MiB;
constexpr size_t WS_RS2 = WS_MIXS + MiB / 2;
constexpr size_t WS_NEED = WS_PEAK;
static_assert(WS_H + (size_t)MREAL * DFF * 2 <= WS_HN && WS_HN + (size_t)MREAL * ROWB <= WS_X1 && WS_X1 + (size_t)MPR * ROWB <= WS_MIXS && WS_MIXS + 3 * MiB <= WS_PEAK && WS_B <= WS_HN, "d_ws map");
static_assert(WS_PEAK <= 512 * MiB, "fits the 512 MiB workspace");

constexpr int NWAVES = 8;
constexpr int LDS_BYTES = 147456;
constexpr int L_K = 0, L_VT = 36864, L_UC = 73728, L_WT = 108544, L_PAR = 126976, L_SEG = 129024, L_CAR = 133120, L_SMP = 133632;
constexpr int KST = 72, UST = 68;
constexpr int L_MISC = 147392;
static_assert(L_SMP + 8 * 1024 <= L_MISC && L_MISC + 8 <= LDS_BYTES, "LDS map");
constexpr size_t CTL_BYTES = 131072;
constexpr size_t WS_CNT = 16384, CNT_BANK = 128 * 64 * 4;
constexpr size_t WS_FLAG = WS_CNT + 3 * CNT_BANK;
constexpr size_t WS_RS = 262144;

struct Args { const float* in[22]; float* out; unsigned char* ws; };
enum { I_XP = 0, I_XS, I_CK, I_CV, I_SC, I_SL, I_WIN, I_WOUT, I_SINK, I_CW, I_CB, I_WA, I_BA, I_WX, I_BX, I_LAM, I_WUP, I_WDN, I_GPM, I_GQM, I_GPF, I_GQF };

__device__ __forceinline__ void p0_transpose_item(const float* W, int K, int N, bf16* WT, LAS float* scr, int item, int lane, const float* gk = nullptr) {
    const int nblk = N / 32, kb = item / nblk, nb = item % nblk, k0 = 64 * kb, n0 = 32 * nb;
    float wv[32];
#pragma unroll
    for (int i = 0; i < 32; ++i) { const int kk = 2 * i + (lane >> 5); wv[i] = W[(size_t)(k0 + kk) * N + n0 + (lane & 31)]; }
    if (gk) {
#pragma unroll
        for (int i = 0; i < 32; ++i) wv[i] *= gk[k0 + 2 * i + (lane >> 5)]; }
#pragma unroll
    for (int i = 0; i < 32; ++i) { const int kk = 2 * i + (lane >> 5); scr[kk * 33 + (lane & 31)] = wv[i]; }
    asm volatile("s_waitcnt lgkmcnt(0)" ::: "memory");
    const int c = lane & 7;
#pragma unroll
    for (int j = 0; j < 4; ++j) { const int n = (lane >> 3) + 8 * j; const LAS float* s = scr + (8 * c) * 33 + n;
        v4u o; o.x = pk2(s[0 * 33], s[1 * 33]); o.y = pk2(s[2 * 33], s[3 * 33]); o.z = pk2(s[4 * 33], s[5 * 33]); o.w = pk2(s[6 * 33], s[7 * 33]);
        *(v4u*)(WT + (size_t)(n0 + n) * K + k0 + 8 * c) = o; }
    asm volatile("s_waitcnt lgkmcnt(0)" ::: "memory");
}
__device__ __forceinline__ void rows2_to_bf16(const float* xa, const float* xb, bool has_b, bf16* oa, bf16* ob, float* rsa_out, float* rsb_out, int lane) {
    const f32x4* ra = (const f32x4*)xa + lane; const f32x4* rb = (const f32x4*)xb + lane;
    f32x4 va[4], vb[4]; float sa = 0.f, sb = 0.f;
#pragma unroll
    for (int j = 0; j < 4; ++j) { va[j] = ra[64 * j]; vb[j] = has_b ? rb[64 * j] : (f32x4){0.f, 0.f, 0.f, 0.f}; }
#pragma unroll
    for (int j = 0; j < 4; ++j) { sa += (va[j].x * va[j].x + va[j].y * va[j].y) + (va[j].z * va[j].z + va[j].w * va[j].w); sb += (vb[j].x * vb[j].x + vb[j].y * vb[j].y) + (vb[j].z * vb[j].z + vb[j].w * vb[j].w); }
#pragma unroll
    for (int o = 1; o < 64; o <<= 1) { sa += __shfl_xor(sa, o); sb += __shfl_xor(sb, o); }
    const float rsa = 1.0f / sqrtf(sa * (1.f / DM) + EPS), rsb = 1.0f / sqrtf(sb * (1.f / DM) + EPS);
    unsigned long long* o8a = (unsigned long long*)oa + lane; unsigned long long* o8b = (unsigned long long*)ob + lane;
#pragma unroll
    for (int j = 0; j < 4; ++j) { const f32x4 pa = va[j] * rsa, pb = vb[j] * rsb;
        o8a[64 * j] = (unsigned long long)pk2(pa.x, pa.y) | ((unsigned long long)pk2(pa.z, pa.w) << 32);
        if (has_b) o8b[64 * j] = (unsigned long long)pk2(pb.x, pb.y) | ((unsigned long long)pk2(pb.z, pb.w) << 32); }
    if (lane == 0) { *rsa_out = rsa; if (has_b) *rsb_out = rsb; }
}
__device__ __forceinline__ void p0_prologue(const Args& A, LAS unsigned char* lds, int G) {
    const int tid = opaque_tid(), lane = tid & 63, wave = __builtin_amdgcn_readfirstlane(tid >> 6);
    LAS float* scr = (LAS float*)(lds + wave * 16384);
    const int gw = blockIdx.x * NWAVES + wave, NGW = G * NWAVES;
    constexpr int I_1 = (DM / 64) * (DIN / 32), I_2 = (DM / 64) * (DM / 32), I_3 = (DM / 64) * (DFF / 32), I_4 = (DFF / 64) * (DM / 32);
    constexpr int NITEMS = I_1 + I_2 + I_3 + I_4;
    for (int it = gw; it < NITEMS; it += NGW) {
        int r = it;
        if (r < I_1) { p0_transpose_item(A.in[I_WIN], DM, DIN, (bf16*)(A.ws + WS_WIN), scr, r, lane, A.in[I_GPM]); continue; } r -= I_1;
        if (r < I_2) { p0_transpose_item(A.in[I_WOUT], DM, DM, (bf16*)(A.ws + WS_WOUT), scr, r, lane); continue; } r -= I_2;
        if (r < I_3) { p0_transpose_item(A.in[I_WUP], DM, DFF, (bf16*)(A.ws + WS_WUP), scr, r, lane, A.in[I_GPF]); continue; } r -= I_3;
        p0_transpose_item(A.in[I_WDN], DFF, DM, (bf16*)(A.ws + WS_WDN), scr, r, lane);
    }
    { const f32x4* ck = (const f32x4*)A.in[I_CK]; const f32x4* cv = (const f32x4*)A.in[I_CV]; f32x4* ok = (f32x4*)(A.out + O_KWS); f32x4* ov = (f32x4*)(A.out + O_VWS);
      const int NT = G * NWAVES * 64;
#pragma unroll 4
      for (int i = gw * 64 + lane; i < DBATCH * 127 * 64; i += NT) { const int bs = i / (127 * 64), r = i - bs * (127 * 64);
          ok[(size_t)bs * 8192 + r] = ck[(size_t)bs * 8192 + 64 + r]; ov[(size_t)bs * 8192 + r] = cv[(size_t)bs * 8192 + 64 + r]; } }
    bf16* XN = (bf16*)(A.ws + WS_XS);
    for (int m = gw; m < MREAL; m += 2 * NGW) { const int m2 = m + NGW; const bool hb = m2 < MREAL; const int mb = hb ? m2 : m;
        const float* sa = (m < MPR) ? A.in[I_XP] + (size_t)m * DM : A.in[I_XS] + (size_t)(m - MPR) * DM;
        const float* sb = (mb < MPR) ? A.in[I_XP] + (size_t)mb * DM : A.in[I_XS] + (size_t)(mb - MPR) * DM;
        rows2_to_bf16(sa, sb, hb, XN + (size_t)m * DM, XN + (size_t)mb * DM, (float*)(A.ws + WS_RS) + m, (float*)(A.ws + WS_RS) + mb, lane); }
}

#define MFMA16(a, b, c) __builtin_amdgcn_mfma_f32_16x16x32_bf16((a), (b), (c), 0, 0, 0)
#define LDS_FENCE() asm volatile("s_waitcnt lgkmcnt(0)" ::: "memory")

struct P2Regs { v4u k[2], v[2], u[5]; };
struct P2Cur { bf16x8 q[2]; v2u ga[4], gr[4], gb[4]; };
struct P2Off { unsigned k[2], v[2], u, q, gt; };
#define RAW_BARRIER() do { asm volatile("s_waitcnt lgkmcnt(0)" ::: "memory"); __builtin_amdgcn_s_barrier(); asm volatile("" ::: "memory"); } while (0)

__device__ __forceinline__ void p2_issue(const char* zc, const P2Off& O, P2Regs& R) {
#pragma unroll
    for (int it = 0; it < 2; ++it) R.k[it] = *(const v4u*)(zc + O.k[it]);
#pragma unroll
    for (int it = 0; it < 2; ++it) R.v[it] = *(const v4u*)(zc + O.v[it]);
}
__device__ __forceinline__ void p2_issue_u(const char* zc, const P2Off& O, P2Regs& R) {
#pragma unroll
    for (int i = 0; i < 5; ++i) R.u[i] = *(const v4u*)(zc + (long)(i - 3) * (DIN * 2) + O.u);
}
__device__ __forceinline__ void p2_issue_q(const char* zc, const P2Off& O, P2Cur& Q) {
    Q.q[0] = *(const bf16x8*)(zc + O.q); Q.q[1] = *(const bf16x8*)(zc + O.q + 64);
}
__device__ __forceinline__ void p2_issue_gates(const char* zc, const P2Off& O, P2Cur& Q) {
#pragma unroll
    for (int nt = 0; nt < 4; ++nt) {
        Q.ga[nt] = *(const v2u*)(zc + O.gt + 32 * nt); Q.gr[nt] = *(const v2u*)(zc + O.gt + 32 * nt + (C_GR - C_GA) * 2); Q.gb[nt] = *(const v2u*)(zc + (O.gt + 32 * nt - (unsigned)((C_GA - C_G) * 2))); }
}
__device__ __forceinline__ v2u merge4(v2u gav, v2u grv, v2u gbv, f32x4 o, f32x4 h) {
    constexpr float L2E = 1.4426950408889634f;
    const f32x4 ga = (f32x4){bflo(gav.x), bfhi(gav.x), bflo(gav.y), bfhi(gav.y)}, gr = (f32x4){bflo(grv.x), bfhi(grv.x), bflo(grv.y), bfhi(grv.y)}, gb = (f32x4){bflo(gbv.x), bfhi(gbv.x), bflo(gbv.y), bfhi(gbv.y)};
    const f32x4 xa = ga * (-L2E), xr = gr * (-L2E), xg = gb * (gb * gb * (-0.044715f * 1.5957691216057308f * L2E) + (-1.5957691216057308f * L2E));
    f32x4 ea, er, eg;
#pragma unroll
    for (int j = 0; j < 4; ++j) { ea[j] = __builtin_amdgcn_exp2f(xa[j]); er[j] = __builtin_amdgcn_exp2f(xr[j]); eg[j] = __builtin_amdgcn_exp2f(xg[j]); }
    const f32x4 da = ea + 1.0f, dr = (er + 1.0f) * (eg + 1.0f);
    f32x4 ra, rr;
#pragma unroll
    for (int j = 0; j < 4; ++j) { ra[j] = __builtin_amdgcn_rcpf(da[j]); rr[j] = __builtin_amdgcn_rcpf(dr[j]); }
    const f32x4 m = o * ra + gb * h * rr;
    return (v2u){pk2(m[0], m[1]), pk2(m[2], m[3])};
}
__device__ __forceinline__ P2Off p2_make_off(int tid, int wave, int n) {
    const int lane = tid & 63, g = lane >> 4, lq = lane & 15, kvh = n >> 2;
    P2Off O;
#pragma unroll
    for (int it = 0; it < 2; ++it) { const int i = tid + 512 * it, key = i >> 3, dg = i & 7; O.k[it] = (unsigned)(key * DIN + C_K + 64 * kvh + 8 * dg) * 2u; }
#pragma unroll
    for (int it = 0; it < 2; ++it) { const int i = tid + 512 * it, key = i >> 3, dg = i & 7; O.v[it] = (unsigned)(key * DIN + C_V + 64 * kvh + 8 * dg) * 2u; }
    const int ct0 = 16 * wave + 2 * (lane >> 3);
    O.u = (unsigned)(ct0 * DIN + C_U + 64 * n + 8 * (lane & 7)) * 2u;
    O.q = (unsigned)((16 * wave + lq) * DIN + 64 * n + C_Q + 8 * g) * 2u;
    O.gt = (unsigned)((16 * wave + lq) * DIN + 64 * n + C_GA + 4 * g) * 2u;
    return O;
}
__device__ __forceinline__ void p2_prompt_unit(const Args& A, LAS unsigned char* lds, int b, int n) {
    const int tid0 = opaque_tid();
    const int wave = __builtin_amdgcn_readfirstlane(tid0 >> 6);
    const int kvh = n >> 2;
    const bf16* Z = (const bf16*)(A.ws + WS_B);
    bf16* MG = (bf16*)(A.ws + WS_A);
    float* out = A.out;
    LAS bf16* Kl = (LAS bf16*)(lds + L_K); LAS bf16* Vt = (LAS bf16*)(lds + L_VT); LAS float* UC = (LAS float*)(lds + L_UC);
    LAS bf16* WT = (LAS bf16*)(lds + L_WT); LAS float* PAR = (LAS float*)(lds + L_PAR); LAS float* SEG = (LAS float*)(lds + L_SEG); LAS float* CAR = (LAS float*)(lds + L_CAR);
    const char* zu = (const char*)Z + (size_t)b * SEQ * DIN * 2;
    P2Regs R;
    { const int tid = tid0; const P2Off O = p2_make_off(tid, wave, n);
    p2_issue(zu, O, R); p2_issue_u(zu, O, R);
    if (tid < 64) { const int ch = 64 * n + tid;
#pragma unroll
        for (int i = 0; i < 4; ++i) PAR[i * 64 + tid] = A.in[I_CW][i * DM + ch];
        PAR[4 * 64 + tid] = A.in[I_CB][ch]; PAR[5 * 64 + tid] = -1.4426950408889634f * A.in[I_BA][ch]; PAR[6 * 64 + tid] = -1.4426950408889634f * A.in[I_BX][ch];
        PAR[7 * 64 + tid] = -8.0f * 1.4426950408889634f * log1pf(expf(-A.in[I_LAM][ch]));
        CAR[tid] = 0.f; CAR[64 + tid] = 0.f; }
    { const int c = tid >> 3, dg = tid & 7; const float* wa = A.in[I_WA] + (size_t)n * 4096 + c * 64 + 8 * dg; const float* wx = A.in[I_WX] + (size_t)n * 4096 + c * 64 + 8 * dg;
#pragma unroll
        for (int e = 0; e < 8; ++e) { WT[(8 * dg + e) * KST + c] = f2bf(wa[e]); WT[64 * KST + (8 * dg + e) * KST + c] = f2bf(wx[e]); } }
    for (int i = tid; i < 128 * KST * 2 / 16; i += 512) *(LAS v4u*)((LAS unsigned char*)Kl + 128 * KST * 2 + i * 16) = (v4u){0u, 0u, 0u, 0u};
    for (int i = tid; i < 128 * KST * 2 / 16; i += 512) *(LAS v4u*)((LAS unsigned char*)Vt + 128 * KST * 2 + i * 16) = (v4u){0u, 0u, 0u, 0u};
    RAW_BARRIER(); }
    const float sink = A.in[I_SINK][n];

    for (int c = 0; c < 16; ++c) {
        int tid = tid0; asm volatile("" : "+v"(tid));
        const int lane = tid & 63, g = lane >> 4, lq = lane & 15, ct0 = 16 * wave + 2 * (lane >> 3);
        const P2Off O = p2_make_off(tid, wave, n);
        const int m0 = b * SEQ + c * 128, hc = c & 1, hp = hc ^ 1;
        const char* zc = zu + (size_t)c * 128 * DIN * 2;
        P2Cur Q; p2_issue_q(zc, O, Q);
#pragma unroll
        for (int it = 0; it < 2; ++it) { const int i = tid + 512 * it, key = i >> 3, dg = i & 7;
            const v4u kv = R.k[it];
            *(LAS v4u*)(Kl + (hc * 128 + key) * KST + 8 * dg) = kv; }
#pragma unroll
        for (int it = 0; it < 2; ++it) { const int i = tid + 512 * it, key = i >> 3, dg = i & 7;
            *(LAS v4u*)(Vt + (hc * 128 + key) * KST + 8 * dg) = R.v[it]; }

        { const int tp = lane >> 3, c8 = 8 * (lane & 7), t0 = 16 * wave + 2 * tp;
          float a0[8], a1[8];
          { const f32x4 b0 = *(LAS f32x4*)(PAR + 4 * 64 + c8), b1 = *(LAS f32x4*)(PAR + 4 * 64 + c8 + 4);
            a0[0] = b0.x; a0[1] = b0.y; a0[2] = b0.z; a0[3] = b0.w; a0[4] = b1.x; a0[5] = b1.y; a0[6] = b1.z; a0[7] = b1.w;
#pragma unroll
            for (int e = 0; e < 8; ++e) a1[e] = a0[e]; }
#pragma unroll
          for (int i = 0; i < 5; ++i) { v4u uv = R.u[i];
              if (c == 0 && t0 - 3 + i < 0) uv = (v4u){0u, 0u, 0u, 0u};
              const float uf[8] = {bflo(uv.x), bfhi(uv.x), bflo(uv.y), bfhi(uv.y), bflo(uv.z), bfhi(uv.z), bflo(uv.w), bfhi(uv.w)};
              if (i < 4) { const f32x4 w0 = *(LAS f32x4*)(PAR + i * 64 + c8), w1 = *(LAS f32x4*)(PAR + i * 64 + c8 + 4);
                  const float wv[8] = {w0.x, w0.y, w0.z, w0.w, w1.x, w1.y, w1.z, w1.w};
#pragma unroll
                  for (int e = 0; e < 8; ++e) a0[e] += wv[e] * uf[e]; }
              if (i > 0) { const f32x4 w0 = *(LAS f32x4*)(PAR + (i - 1) * 64 + c8), w1 = *(LAS f32x4*)(PAR + (i - 1) * 64 + c8 + 4);
                  const float wv[8] = {w0.x, w0.y, w0.z, w0.w, w1.x, w1.y, w1.z, w1.w};
#pragma unroll
                  for (int e = 0; e < 8; ++e) a1[e] += wv[e] * uf[e]; } }
          *(LAS f32x4*)(UC + t0 * UST + c8) = (f32x4){a0[0], a0[1], a0[2], a0[3]}; *(LAS f32x4*)(UC + t0 * UST + c8 + 4) = (f32x4){a0[4], a0[5], a0[6], a0[7]};
          *(LAS f32x4*)(UC + (t0 + 1) * UST + c8) = (f32x4){a1[0], a1[1], a1[2], a1[3]}; *(LAS f32x4*)(UC + (t0 + 1) * UST + c8 + 4) = (f32x4){a1[4], a1[5], a1[6], a1[7]}; }
        p2_issue(zc + (size_t)128 * DIN * 2, O, R);
        LDS_FENCE();
        f32x4 ga[4], gx[4];
#pragma unroll
        for (int nt = 0; nt < 4; ++nt) { ga[nt] = (f32x4){0.f, 0.f, 0.f, 0.f}; gx[nt] = (f32x4){0.f, 0.f, 0.f, 0.f}; }
#pragma unroll
        for (int ks = 0; ks < 2; ++ks) {
            const f32x4 u0 = *(LAS f32x4*)(UC + (16 * wave + lq) * UST + 32 * ks + 8 * g), u1 = *(LAS f32x4*)(UC + (16 * wave + lq) * UST + 32 * ks + 8 * g + 4);
            v4u ap; ap.x = pk2(u0.x, u0.y); ap.y = pk2(u0.z, u0.w); ap.z = pk2(u1.x, u1.y); ap.w = pk2(u1.z, u1.w);
            const bf16x8 af = __builtin_bit_cast(bf16x8, ap);
#pragma unroll
            for (int nt = 0; nt < 4; ++nt) {
                const bf16x8 ba = *(LAS bf16x8*)(WT + (16 * nt + lq) * KST + 32 * ks + 8 * g);
                const bf16x8 bx = *(LAS bf16x8*)(WT + 64 * KST + (16 * nt + lq) * KST + 32 * ks + 8 * g);
                ga[nt] = MFMA16(af, ba, ga[nt]); gx[nt] = MFMA16(af, bx, gx[nt]); } }
        float av[4][4], PA[4], PB[4];
#pragma unroll
        for (int nt = 0; nt < 4; ++nt) { const int ch = 16 * nt + lq;
            const float nba = PAR[5 * 64 + ch], nbx = PAR[6 * 64 + ch], spc = PAR[7 * 64 + ch];
            const f32x4 ea4 = ga[nt] * (-1.4426950408889634f) + nba, ex4 = gx[nt] * (-1.4426950408889634f) + nbx;
            f32x4 r4, i4, a4, m4, u4;
#pragma unroll
            for (int j = 0; j < 4; ++j) { r4[j] = __builtin_amdgcn_rcpf(1.0f + __builtin_amdgcn_exp2f(ea4[j])); i4[j] = __builtin_amdgcn_rcpf(1.0f + __builtin_amdgcn_exp2f(ex4[j]));
                u4[j] = UC[(16 * wave + 4 * g + j) * UST + ch]; }
            const f32x4 la4 = r4 * spc;
#pragma unroll
            for (int j = 0; j < 4; ++j) a4[j] = __builtin_amdgcn_exp2f(la4[j]);
            const f32x4 om = 1.0f - a4 * a4;
#pragma unroll
            for (int j = 0; j < 4; ++j) m4[j] = __builtin_amdgcn_sqrtf(om[j]);
            if (c == 0 && wave == 0 && g == 0) m4[0] = 1.0f;
            const f32x4 b4 = m4 * i4 * u4;
            float Aq = 1.f, Bq = 0.f;
#pragma unroll
            for (int j = 0; j < 4; ++j) { av[nt][j] = a4[j]; UC[(16 * wave + 4 * g + j) * UST + ch] = b4[j]; Bq = a4[j] * Bq + b4[j]; Aq = Aq * a4[j]; }
            float pa = 1.f, pb = 0.f, wa_ = 1.f, wb_ = 0.f;
#pragma unroll
            for (int k = 0; k < 4; ++k) { const float Ak = __shfl(Aq, lq + 16 * k), Bk = __shfl(Bq, lq + 16 * k);
                if (k < g) { pb = Ak * pb + Bk; pa = pa * Ak; }
                wb_ = Ak * wb_ + Bk; wa_ = wa_ * Ak; }
            PA[nt] = pa; PB[nt] = pb;
            if (g == 0) { SEG[wave * 64 + ch] = wa_; SEG[512 + wave * 64 + ch] = wb_; } }
        RAW_BARRIER();
        p2_issue_gates(zc, O, Q);
        p2_issue_u(zc + (size_t)128 * DIN * 2, O, R);
#pragma unroll
        for (int nt = 0; nt < 4; ++nt) { const int ch = 16 * nt + lq;
            float h = CAR[hc * 64 + ch];
#pragma unroll
            for (int w2 = 0; w2 < 7; ++w2) { const float sa = SEG[w2 * 64 + ch], sb = SEG[512 + w2 * 64 + ch]; h = (w2 < wave) ? sa * h + sb : h; }
            h = PA[nt] * h + PB[nt];
#pragma unroll
            for (int j = 0; j < 4; ++j) { const int t = 16 * wave + 4 * g + j; h = av[nt][j] * h + UC[t * UST + ch]; UC[t * UST + ch] = h; }
            if (wave == 7 && g == 3) CAR[hp * 64 + ch] = h; }
        LDS_FENCE();
        {
            f32x4 sT[9];
#pragma unroll
            for (int jt = 0; jt < 9; ++jt) { const int kt = wave + jt; const int base = ((kt < 8) ? hp : hc) * 128 + (kt & 7) * 16;
                const LAS bf16* kp = Kl + (base + lq) * KST + 8 * g;
                const bf16x8 k0 = *(const LAS bf16x8*)kp, k1 = *(const LAS bf16x8*)(kp + 32);
                f32x4 acc = (f32x4){0.f, 0.f, 0.f, 0.f};
                acc = MFMA16(k0, Q.q[0], acc); acc = MFMA16(k1, Q.q[1], acc); sT[jt] = acc;
                }
            const int qi = 16 * wave + lq;
            float mx = -INFINITY;
#pragma unroll
            for (int jt = 0; jt < 9; ++jt)
#pragma unroll
                for (int j = 0; j < 4; ++j) { const int kj = 16 * (wave + jt) + 4 * g + j;
                    bool valid = (c > 0 || kj >= 128);
                    if (jt == 0) valid = valid && (kj >= qi);
                    if (jt == 8) valid = valid && (kj <= qi + 128);
                    const float sv = valid ? sT[jt][j] : -INFINITY; sT[jt][j] = sv; mx = fmaxf(mx, sv); }
            mx = fmaxf(mx, __shfl_xor(mx, 16)); mx = fmaxf(mx, __shfl_xor(mx, 32));
            constexpr float SC = 0.125f * 1.4426950408889634f;
            const float mxl = fmaxf(mx * SC, sink * 1.4426950408889634f);
            f32x4 sum4 = (f32x4){0.f, 0.f, 0.f, 0.f};
#pragma unroll
            for (int jt = 0; jt < 9; ++jt) { const f32x4 e4 = sT[jt] * SC - mxl; f32x4 p4;
#pragma unroll
                for (int j = 0; j < 4; ++j) p4[j] = __builtin_amdgcn_exp2f(e4[j]);
                sT[jt] = p4; sum4 += p4; }
            float sum = (sum4[0] + sum4[1]) + (sum4[2] + sum4[3]);
            sum += __shfl_xor(sum, 16); sum += __shfl_xor(sum, 32);
            const float inv = __builtin_amdgcn_rcpf(sum + __builtin_amdgcn_exp2f(sink * 1.4426950408889634f - mxl));
            f32x4 oT[4];
#pragma unroll
            for (int nt = 0; nt < 4; ++nt) oT[nt] = (f32x4){0.f, 0.f, 0.f, 0.f};
#pragma unroll
            for (int kk = 0; kk < 5; ++kk) { const int jt0 = 2 * kk, jt1 = (2 * kk + 1 < 9) ? 2 * kk + 1 : 8;
                v4u pp; pp.x = pk2(sT[jt0][0], sT[jt0][1]); pp.y = pk2(sT[jt0][2], sT[jt0][3]);
                if (kk < 4) { pp.z = pk2(sT[jt1][0], sT[jt1][1]); pp.w = pk2(sT[jt1][2], sT[jt1][3]); } else { pp.z = 0u; pp.w = 0u; }
                const bf16x8 pf = __builtin_bit_cast(bf16x8, pp);
                const int kt0 = wave + jt0; int kt1 = wave + 2 * kk + 1; kt1 = kt1 > 15 ? 15 : kt1;
                const int base0 = ((kt0 < 8) ? hp : hc) * 128 + (kt0 & 7) * 16, base1 = ((kt1 < 8) ? hp : hc) * 128 + (kt1 & 7) * 16;
#pragma unroll
                for (int nt = 0; nt < 4; ++nt) { const LAS bf16* vp = Vt + (4 * g + (lq >> 2)) * KST + 16 * nt + 4 * (lq & 3);
                    const s16x4 t0 = __builtin_amdgcn_ds_read_tr16_b64_v4i16((LAS s16x4*)(vp + base0 * KST)), t1 = __builtin_amdgcn_ds_read_tr16_b64_v4i16((LAS s16x4*)(vp + base1 * KST));
                    const v2u v0 = __builtin_bit_cast(v2u, t0), v1 = __builtin_bit_cast(v2u, t1);
                    const v4u vv = (v4u){v0.x, v0.y, v1.x, v1.y};
                    oT[nt] = MFMA16(__builtin_bit_cast(bf16x8, vv), pf, oT[nt]); } }
            const size_t row = (size_t)(m0 + 16 * wave + lq);
#pragma unroll
            for (int nt = 0; nt < 4; ++nt) { const int d0 = 16 * nt + 4 * g;
                const v2u gav = Q.ga[nt], grv = Q.gr[nt], gbv = Q.gb[nt];
                const f32x4 h4 = *(LAS f32x4*)(UC + (16 * wave + lq) * UST + d0);
                *(v2u*)(MG + row * DM + 64 * n + d0) = merge4(gav, grv, gbv, oT[nt] * inv, h4); }
        }
        RAW_BARRIER();
    }
    { const int mL = b * SEQ + 15 * 128; int tq = tid0; asm volatile("" : "+v"(tq));
      if (tq < 64) out[O_LP + (size_t)b * DM + 64 * n + tq] = CAR[tq];
      if (tq < 192) { const int j = tq >> 6, ch = tq & 63;
          out[O_CP + (size_t)(b * 3 + j) * DM + 64 * n + ch] = bf2f(Z[(size_t)(mL + 125 + j) * DIN + C_U + 64 * n + ch]); }
      {
          { const int i = tq; const int which = i >> 8, key = 32 * (n & 3) + ((i >> 3) & 31), dg = i & 7;
              const v4u kv = *(const v4u*)(Z + (size_t)(mL + key) * DIN + (which ? C_V : C_K) + 64 * kvh + 8 * dg);
              float* o = out + (which ? O_VWP : O_KWP) + ((size_t)(b * 128 + key) * 4 + kvh) * 64 + 8 * dg;
              *(f32x4*)o = (f32x4){bflo(kv.x), bfhi(kv.x), bflo(kv.y), bfhi(kv.y)}; *(f32x4*)(o + 4) = (f32x4){bflo(kv.z), bfhi(kv.z), bflo(kv.w), bfhi(kv.w)}; } }
      RAW_BARRIER(); }
}

__device__ __forceinline__ void p2_sample_item(const Args& A, LAS float* scr, int bs, int n, int lane) {
    const int kvh = n >> 2, cg_ = 64 * n + lane;
    const size_t row = (size_t)MPR + bs;
    const bf16* zr = (const bf16*)(A.ws + WS_B) + row * DIN;
    bf16* MG = (bf16*)(A.ws + WS_A);
    float* out = A.out;
    const float un = bf2f(zr[C_U + cg_]);
    const float* sc = A.in[I_SC] + (size_t)bs * 3 * DM + cg_;
    const float s0 = sc[0], s1 = sc[DM], s2 = sc[2 * DM];
    const float* cw = A.in[I_CW] + cg_;
    const float uc = A.in[I_CB][cg_] + cw[0] * s0 + cw[DM] * s1 + cw[2 * DM] * s2 + cw[3 * DM] * un;
    out[O_CS + ((size_t)bs * 3 + 0) * DM + cg_] = s1; out[O_CS + ((size_t)bs * 3 + 1) * DM + cg_] = s2; out[O_CS + ((size_t)bs * 3 + 2) * DM + cg_] = un;
    float ra = A.in[I_BA][cg_], rx = A.in[I_BX][cg_];
    const float* wa = A.in[I_WA] + (size_t)n * 4096 + lane; const float* wx = A.in[I_WX] + (size_t)n * 4096 + lane;
#pragma unroll 32
    for (int c = 0; c < 64; ++c) { const float ucc = __shfl(uc, c); ra += ucc * wa[c * 64]; rx += ucc * wx[c * 64]; }
    const float r = sigmoidf_(ra), ig = sigmoidf_(rx);
    const float sp = log1pf(expf(-A.in[I_LAM][cg_]));
    const float la = -8.0f * r * sp, a = __expf(la);
    const float mult = sqrtf(fmaxf(1.0f - __expf(2.0f * la), 0.f));
    const float h = a * A.in[I_SL][(size_t)bs * DM + cg_] + mult * ig * uc;
    out[O_LS + (size_t)bs * DM + cg_] = h;
    const float rnn = gelu_tanh(bf2f(zr[C_G + cg_])) * h;
    const float qv = bf2f(zr[C_Q + cg_]);
    const float knew = bf2f(zr[C_K + 64 * kvh + lane]), vnew = bf2f(zr[C_V + 64 * kvh + lane]);
    scr[lane] = qv;
    LDS_FENCE();
    const float* ck = A.in[I_CK] + ((size_t)(bs * 128 + lane) * 4 + kvh) * 64;
    float d0 = 0.f, d1 = 0.f;
#pragma unroll
    for (int dd = 0; dd < 16; ++dd) { const f32x4 q4 = *(LAS f32x4*)(scr + 4 * dd); const f32x4 ka = ((const f32x4*)ck)[dd], kb = ((const f32x4*)(ck + 64 * 256))[dd];
        d0 += (q4.x * ka.x + q4.y * ka.y) + (q4.z * ka.z + q4.w * ka.w); d1 += (q4.x * kb.x + q4.y * kb.y) + (q4.z * kb.z + q4.w * kb.w); }
    const float d2 = wave_sum(qv * knew);
    const float sink = A.in[I_SINK][n];
    const float sa = d0 * 0.125f, sb = d1 * 0.125f, sn = d2 * 0.125f;
    float mx = wave_max(fmaxf(sa, sb)); mx = fmaxf(mx, fmaxf(sn, sink));
    const float p0 = __expf(sa - mx), p1 = __expf(sb - mx), p2 = __expf(sn - mx);
    const float den = wave_sum(p0 + p1) + p2 + __expf(sink - mx);
    scr[64 + lane] = p0; scr[128 + lane] = p1;
    LDS_FENCE();
    float o = p2 * vnew;
    const float* cv = A.in[I_CV] + ((size_t)(bs * 128) * 4 + kvh) * 64 + lane;
#pragma unroll 32
    for (int j = 0; j < 128; ++j) o += scr[64 + j] * cv[(size_t)j * 256];
    o = o / den;
    const float merged = sigmoidf_(bf2f(zr[C_GA + cg_])) * o + sigmoidf_(bf2f(zr[C_GR + cg_])) * rnn;
    MG[row * DM + cg_] = f2bf(merged);
    LDS_FENCE();
    if ((n & 3) == 0) { out[O_KWS + ((size_t)(bs * 128 + 127) * 4 + kvh) * 64 + lane] = knew; out[O_VWS + ((size_t)(bs * 128 + 127) * 4 + kvh) * 64 + lane] = vnew; }
}

template <class EpiS>
__device__ __forceinline__ void skinny_items(LAS unsigned char* lds, const bf16* Am, int lda, const bf16* Bt, int ldb, int n_tiles, int ksplit, int item_lo, int item_hi, int which, int G, const EpiS& epi) {
    const int tid = opaque_tid(), lane = tid & 63, wave = __builtin_amdgcn_readfirstlane(tid >> 6), lq = lane & 15, g = lane >> 4;
    if (which >= 0 && (int)(blockIdx.x & 1) != which) return;
    const int first = (which < 0) ? (int)blockIdx.x : (int)(blockIdx.x >> 1), step = (which < 0) ? G : (G >> 1);
    const int n_pairs = n_tiles >> 1;
    LAS f32x4* red = (LAS f32x4*)lds;
    for (int it = item_lo + first; it < item_hi; it += step) {
        const int np = it % n_pairs, kq = it / n_pairs;
        const int kb = kq * 1024 + wave * 128 + 8 * g;
        const bf16* ap = Am + (size_t)lq * lda + kb;
        const bf16* bp = Bt + (size_t)(32 * np + lq) * ldb + kb;
        f32x4 acc[8][2];
#pragma unroll
        for (int rt = 0; rt < 8; ++rt) { acc[rt][0] = (f32x4){0.f, 0.f, 0.f, 0.f}; acc[rt][1] = (f32x4){0.f, 0.f, 0.f, 0.f}; }
#pragma unroll 2
        for (int ks = 0; ks < 4; ++ks) {
            const bf16x8 b0 = *(const bf16x8*)(bp + 32 * ks), b1 = *(const bf16x8*)(bp + (size_t)16 * ldb + 32 * ks);
            bf16x8 a[8];
#pragma unroll
            for (int rt = 0; rt < 8; ++rt) a[rt] = *(const bf16x8*)(ap + (size_t)(16 * rt) * lda + 32 * ks);
#pragma unroll
            for (int rt = 0; rt < 8; ++rt) { acc[rt][0] = MFMA16(b0, a[rt], acc[rt][0]); acc[rt][1] = MFMA16(b1, a[rt], acc[rt][1]); } }
        RAW_BARRIER();
#pragma unroll
        for (int rt = 0; rt < 8; ++rt) { red[(wave * 16 + rt * 2 + 0) * 64 + lane] = acc[rt][0]; red[(wave * 16 + rt * 2 + 1) * 64 + lane] = acc[rt][1]; }
        RAW_BARRIER();
#pragma unroll
        for (int ct = 0; ct < 2; ++ct) { f32x4 sum = red[(wave * 2 + ct) * 64 + lane];
#pragma unroll
            for (int w2 = 1; w2 < 8; ++w2) sum += red[(w2 * 16 + wave * 2 + ct) * 64 + lane];
            epi(16 * wave + lq, 16 * (2 * np + ct) + 4 * g, kq, sum); }
    }
    RAW_BARRIER();
}

__device__ __forceinline__ void p3b_rows(const Args& A, int G, int wg_lo) {
    if ((int)blockIdx.x < wg_lo || (int)blockIdx.x >= wg_lo + 16) return;
    const int tid = opaque_tid(), lane = tid & 63, wave = __builtin_amdgcn_readfirstlane(tid >> 6);
    const int gw = ((int)blockIdx.x - wg_lo) * NWAVES + wave, NGW = 16 * NWAVES;
    const float* MIX = (const float*)(A.ws + WS_MIXS) - (size_t)MPR * DM; bf16* HN = (bf16*)(A.ws + WS_HN);
    const f32x4* g1 = (const f32x4*)A.in[I_GQM] + lane;
    for (int m = MPR + gw; m < MREAL; m += NGW) {
        unsigned long long* o8 = (unsigned long long*)(HN + (size_t)m * DM) + lane;
        const f32x4* mr = (const f32x4*)(MIX + (size_t)m * DM) + lane;
        const f32x4* xr = (const f32x4*)((m < MPR) ? A.in[I_XP] + (size_t)m * DM : A.in[I_XS] + (size_t)(m - MPR) * DM) + lane;
        f32x4* orow = (f32x4*)(A.out + (size_t)m * DM) + lane;
        f32x4 v[4], xv[4]; float s = 0.f;
#pragma unroll
        for (int j = 0; j < 4; ++j) { v[j] = mr[64 * j]; xv[j] = xr[64 * j]; s += (v[j].x * v[j].x + v[j].y * v[j].y) + (v[j].z * v[j].z + v[j].w * v[j].w); }
        const float rstd = 1.0f / sqrtf(wave_sum(s) * (1.f / DM) + EPS);
        float s2 = 0.f;
#pragma unroll
        for (int j = 0; j < 4; ++j) { xv[j] = xv[j] + v[j] * rstd * g1[64 * j]; orow[64 * j] = xv[j];
            s2 += (xv[j].x * xv[j].x + xv[j].y * xv[j].y) + (xv[j].z * xv[j].z + xv[j].w * xv[j].w); }
        const float rstd2 = 1.0f / sqrtf(wave_sum(s2) * (1.f / DM) + EPS);
        if (lane == 0) ((float*)(A.ws + WS_RS2))[m] = rstd2;
#pragma unroll
        for (int j = 0; j < 4; ++j) { const f32x4 o = xv[j];
            o8[64 * j] = (unsigned long long)pk2(o.x, o.y) | ((unsigned long long)pk2(o.z, o.w) << 32); }
    }
    asm volatile("s_waitcnt vmcnt(0)" ::: "memory"); RAW_BARRIER();
    if (tid == 0) { __builtin_amdgcn_fence(__ATOMIC_RELEASE, "agent"); __hip_atomic_fetch_add((unsigned*)(A.ws + WS_FLAG), 1u, __ATOMIC_RELAXED, __HIP_MEMORY_SCOPE_AGENT); }
}
__device__ __forceinline__ void wait_flag(unsigned* flag, unsigned want) {
    if (threadIdx.x == 0) { unsigned sp = 0; while (__hip_atomic_load(flag, __ATOMIC_RELAXED, __HIP_MEMORY_SCOPE_AGENT) < want) { __builtin_amdgcn_s_sleep(2); if (++sp > (1u << 22)) break; }
        __builtin_amdgcn_fence(__ATOMIC_ACQUIRE, "agent"); asm volatile("s_waitcnt vmcnt(0)" ::: "memory"); }
    RAW_BARRIER();
}
__device__ __forceinline__ void p5b_rows(const Args& A, int G) {
    if ((blockIdx.x & 1) || blockIdx.x >= 32) return;
    wait_flag((unsigned*)(A.ws + WS_FLAG) + 64, 128u);
    const int tid = opaque_tid(), lane = tid & 63, wave = __builtin_amdgcn_readfirstlane(tid >> 6);
    const int gw = (int)(blockIdx.x >> 1) * NWAVES + wave, NGW = 16 * NWAVES;
    const float* F = (const float*)(A.ws + WS_A);
    const f32x4* g1 = (const f32x4*)A.in[I_GQF] + lane;
    for (int m = MPR + gw; m < MREAL; m += NGW) {
        const f32x4* fr = (const f32x4*)(F + (size_t)m * DM) + lane;
        f32x4* orow = (f32x4*)(A.out + (size_t)m * DM) + lane;
        f32x4 v[4], xv[4]; float s = 0.f;
        if (m >= MPR) { const f32x4* pr = (const f32x4*)((const float*)(A.ws + WS_WOUT) + (size_t)(m - MPR) * DM) + lane;
#pragma unroll
            for (int j = 0; j < 4; ++j) v[j] = (pr[64 * j] + pr[64 * j + DBATCH * DM / 4]) + (pr[64 * j + 2 * (DBATCH * DM / 4)] + pr[64 * j + 3 * (DBATCH * DM / 4)]); }
        else {
#pragma unroll
            for (int j = 0; j < 4; ++j) v[j] = fr[64 * j]; }
#pragma unroll
        for (int j = 0; j < 4; ++j) { xv[j] = orow[64 * j]; s += (v[j].x * v[j].x + v[j].y * v[j].y) + (v[j].z * v[j].z + v[j].w * v[j].w); }
        const float rstd = 1.0f / sqrtf(wave_sum(s) * (1.f / DM) + EPS);
#pragma unroll
        for (int j = 0; j < 4; ++j) orow[64 * j] = xv[j] + v[j] * rstd * g1[64 * j];
    }
}

__global__ void __launch_bounds__(NWAVES * 64, 2) mega_fwd(Args args) {
    extern __shared__ __attribute__((aligned(16))) unsigned char lds_raw[];
    cg::grid_group grid = cg::this_grid();
    LAS unsigned char* lds = (LAS unsigned char*)lds_raw;
    const int G = gridDim.x;
    unsigned char* ws = args.ws;
    if (threadIdx.x == 0) { ((volatile LAS unsigned*)(lds + L_MISC))[0] = 0u; ((volatile LAS unsigned*)(lds + L_MISC))[1] = 0u; }
    __syncthreads();
    const XcdBarrier bar = xcd_barrier_post((unsigned*)ws, (volatile LAS unsigned*)(lds + L_MISC));

    p0_prologue(args, lds, G);
    if (G == 0x7fffffff) grid.sync();
    xcd_barrier(bar);
    { pg8::Gemm g{(const bf16*)(ws + WS_XS), (const bf16*)(ws + WS_WIN), MPAD, DIN, DM}; pg8::StaticOrder S; S.init(MPR, DIN, G, (int)blockIdx.x);
      pg8::EpiBf16<0> E{(bf16*)(ws + WS_B), DIN, nullptr};
      pg8::gemm_phase<pg8::EpiBf16<0>, pg8::StaticOrder, true, true>(lds, g, S, E);
      bf16* Zs = (bf16*)(ws + WS_B) + (size_t)MPR * DIN;
      skinny_items(lds, (const bf16*)(ws + WS_XS) + (size_t)MPR * DM, DM, (const bf16*)(ws + WS_WIN), DM, DIN / 16, 1, 0, DIN / 32, -1, G,
                   [Zs](int r, int c, int, const f32x4& a) { *(v2u*)(Zs + (size_t)r * DIN + c) = (v2u){pk2(a[0], a[1]), pk2(a[2], a[3])}; }); }
    xcd_barrier(bar);
    for (int u0 = blockIdx.x; u0 < NBATCH * NHEAD; u0 += G) { const int u = (G == 256) ? (((u0 & 7) * 2 + ((u0 >> 3) >> 4)) << 4) + ((u0 >> 3) & 15) : u0;
        p2_prompt_unit(args, lds, u >> 4, u & 15); }
    { const int tid = opaque_tid(), lane = tid & 63, wave = __builtin_amdgcn_readfirstlane(tid >> 6);
      for (int it = blockIdx.x * NWAVES + wave; it < DBATCH * NHEAD; it += G * NWAVES) p2_sample_item(args, (LAS float*)(lds + L_SMP + wave * 1024), it >> 4, it & 15, lane); }
    xcd_barrier(bar);
    { pg8::Gemm g{(const bf16*)(ws + WS_A), (const bf16*)(ws + WS_WOUT), MPR, DM, DM}; pg8::StaticOrder S; S.init(MPR, DM, G, (int)blockIdx.x);
      pg8::PanelRms st1{(float*)(ws + WS_MIXS + 1 * MiB), (unsigned*)(ws + WS_CNT)}; pg8::PanelPublish st2{(float*)(ws + WS_MIXS + 2 * MiB), (unsigned*)(ws + WS_CNT + CNT_BANK), (float*)(ws + WS_RS2)};
      pg8::EpiRmsResRms E{(const bf16*)(ws + WS_XS), (const float*)(ws + WS_RS), (bf16*)(ws + WS_X1), args.in[I_GQM], st1, st2};
      float* Ms = (float*)(ws + WS_MIXS);
      auto epis = [Ms](int r, int c, int, const f32x4& a) { *(f32x4*)(Ms + (size_t)r * DM + c) = a; };
      skinny_items(lds, (const bf16*)(ws + WS_A) + (size_t)MPR * DM, DM, (const bf16*)(ws + WS_WOUT), DM, DM / 16, 1, 0, DM / 32, 1, G, epis);
      for (int i = 0; i < 2; ++i) { pg8::OneUnit U; U.valid = S.next(i, U.u);
          pg8::gemm_phase<pg8::EpiRmsResRms, pg8::OneUnit, false, true>(lds, g, U, E);
          RAW_BARRIER(); }
    }
    xcd_barrier(bar);
    p3b_rows(args, G, 128);
    { pg8::Gemm g{(const bf16*)(ws + WS_X1), (const bf16*)(ws + WS_WUP), MPAD, DFF, DM}; pg8::StaticOrder S; S.init(MPR, DFF, G, (int)blockIdx.x);
      pg8::EpiBf16<3> E{(bf16*)(ws + WS_H), DFF, (const float*)(ws + WS_RS2)};
      pg8::gemm_phase<pg8::EpiBf16<3>, pg8::StaticOrder, true, true>(lds, g, S, E);
      if (blockIdx.x < DFF / 32) wait_flag((unsigned*)(ws + WS_FLAG), 16u);
      bf16* Hs = (bf16*)(ws + WS_H) + (size_t)MPR * DFF;
      skinny_items(lds, (const bf16*)(ws + WS_HN) + (size_t)MPR * DM, DM, (const bf16*)(ws + WS_WUP), DM, DFF / 16, 1, 0, DFF / 32, -1, G,
                   [Hs, rs2s = (const float*)(ws + WS_RS2) + MPR](int r, int c, int, const f32x4& a) { const float q = rs2s[r], q2 = q * q;
                       const float x0 = fmaxf(a[0], 0.f), x1 = fmaxf(a[1], 0.f), x2 = fmaxf(a[2], 0.f), x3 = fmaxf(a[3], 0.f);
                       *(v2u*)(Hs + (size_t)r * DFF + c) = (v2u){pk2(x0 * x0 * q2, x1 * x1 * q2), pk2(x2 * x2 * q2, x3 * x3 * q2)}; }); }
    xcd_barrier(bar);
    { pg8::Gemm g{(const bf16*)(ws + WS_H), (const bf16*)(ws + WS_WDN), MPR, DM, DFF}; pg8::StaticOrder S; S.init(MPR, DM, G, (int)blockIdx.x);
      pg8::PanelRms st{(float*)(ws + WS_MIXS + 1 * MiB), (unsigned*)(ws + WS_CNT + 2 * CNT_BANK)};
      pg8::EpiRmsRes E{(const bf16*)(ws + WS_X1), args.out, args.in[I_GQF], st};
      float* Fp = (float*)(ws + WS_WOUT);
      auto epis = [Fp](int r, int c, int kq, const f32x4& a) { *(f32x4*)(Fp + ((size_t)kq * DBATCH + r) * DM + c) = a; };
      skinny_items(lds, (const bf16*)(ws + WS_H) + (size_t)MPR * DFF, DFF, (const bf16*)(ws + WS_WDN), DFF, DM / 16, 4, 0, 4 * (DM / 32), 1, G, epis);
      if (blockIdx.x & 1) { asm volatile("s_waitcnt vmcnt(0)" ::: "memory"); RAW_BARRIER();
          if (threadIdx.x == 0) { __builtin_amdgcn_fence(__ATOMIC_RELEASE, "agent"); __hip_atomic_fetch_add((unsigned*)(ws + WS_FLAG) + 64, 1u, __ATOMIC_RELAXED, __HIP_MEMORY_SCOPE_AGENT); } }
      for (int i = 1; i >= 0; --i) { pg8::OneUnit U; U.valid = S.next(i, U.u);
          pg8::gemm_phase<pg8::EpiRmsRes, pg8::OneUnit, false, true>(lds, g, U, E);
          RAW_BARRIER(); }
    }
    p5b_rows(args, G);
}

extern "C" void kernel_launch(void* const* d_in, const int* in_sizes, int n_in, void* d_out, int out_size, void* d_ws, size_t ws_size, hipStream_t stream) {
    static int grid = 0;
    if (grid == 0) {
        if (n_in != 22 || ws_size < WS_NEED) { fprintf(stderr, "kernel_launch: unexpected n_in %d or ws_size %zu (< %zu)\n", n_in, ws_size, (size_t)WS_NEED); grid = -1; return; }
        int dev = 0, cus = 0, per_cu = 0;
        (void)hipGetDevice(&dev);
        (void)hipDeviceGetAttribute(&cus, hipDeviceAttributeMultiprocessorCount, dev);
        (void)hipFuncSetAttribute((const void*)mega_fwd, hipFuncAttributeMaxDynamicSharedMemorySize, LDS_BYTES);
        (void)hipOccupancyMaxActiveBlocksPerMultiprocessor(&per_cu, (const void*)mega_fwd, NWAVES * 64, LDS_BYTES);
        if (per_cu < 1) { fprintf(stderr, "kernel_launch: occupancy query gave %d\n", per_cu); per_cu = 1; }
        (void)hipGetLastError();
        grid = cus * per_cu;
    }
    if (grid < 0) return;
    Args a{};
    for (int i = 0; i < 22; ++i) a.in[i] = (const float*)d_in[i];
    a.out = (float*)d_out; a.ws = (unsigned char*)d_ws;
    if (hipMemsetAsync(d_ws, 0, CTL_BYTES, stream) != hipSuccess) { fprintf(stderr, "kernel_launch: memset failed\n"); return; }
    void* kargs[] = {&a};
    hipError_t e = hipLaunchCooperativeKernel((const void*)mega_fwd, dim3(grid), dim3(NWAVES * 64), kargs, LDS_BYTES, stream);
    if (e != hipSuccess) fprintf(stderr, "cooperative launch failed: %s (grid %d)\n", hipGetErrorString(e), grid);
}
```
